# Optimizing an MI355X kernel written in HIP

```python
import jax, jax.numpy as jnp
from jax import lax
import numpy as np

D_MODEL = 2048
BATCH = 1
SEQ = 8192
DEPTH = 4

N_MIXERS = 4
N_HEADS = 16
HEAD_DIM = 128
MIX_WIDTH = N_HEADS * HEAD_DIM
Q_BLOCK = 128
EPS = 1e-6
NEG_BIG = -1e30

MLA_Q_RANK = 512
MLA_KV_RANK = 256
MLA_NOPE = 128
MLA_ROPE = 64
MLA_V = 128
MLA_QK_DIM = MLA_NOPE + MLA_ROPE
ROPE_THETA = 10000.0
MLA_IN = MLA_Q_RANK + MLA_KV_RANK + MLA_ROPE + MIX_WIDTH

MOBA_BLOCK = 256
MOBA_TOPK = 3
MOBA_Q_CHUNK = 16

QKV_GATE_IN = 4 * MIX_WIDTH

NSA_GROUPS = 4
NSA_HPG = N_HEADS // NSA_GROUPS
NSA_CMP_BLOCK = 32
NSA_CMP_STRIDE = 16
NSA_SEL_BLOCK = 64
NSA_SEL_N = 16
NSA_WINDOW = 512
NSA_Q_CHUNK = 32
NSA_KV_WIDTH = 2 * NSA_GROUPS * HEAD_DIM
NSA_IN = MIX_WIDTH + 3 * NSA_KV_WIDTH + 3 * N_HEADS + MIX_WIDTH

kernel_name = 'hybrid_mla_moba_stickbreak_nsa'


def layers_of(m):
    return len(range(m, DEPTH, N_MIXERS))


def rms_norm(x, g):
    xf = x.astype(jnp.float32)
    y = xf * lax.rsqrt(jnp.mean(xf * xf, axis=-1, keepdims=True) + EPS)
    return (y * g.astype(jnp.float32)).astype(x.dtype)


def alibi_slopes():
    return jnp.asarray(2.0 ** (-8.0 * np.arange(1, N_HEADS + 1) / N_HEADS), dtype=jnp.float32)


def to_heads(t, n, d):
    B, S, _ = t.shape
    return t.reshape(B, S, n, d).transpose(0, 2, 1, 3)


def from_heads(t):
    B, n, S, d = t.shape
    return t.transpose(0, 2, 1, 3).reshape(B, S, n * d)


def rope(x):
    S, R = x.shape[1], x.shape[-1]
    inv_freq = ROPE_THETA ** (-jnp.arange(0, R, 2, dtype=jnp.float32) / R)
    ang = jnp.arange(S, dtype=jnp.float32)[:, None] * inv_freq[None, :]
    cos = jnp.cos(ang)[None, :, None, :]
    sin = jnp.sin(ang)[None, :, None, :]
    x1, x2 = jnp.split(x.astype(jnp.float32), 2, axis=-1)
    return jnp.concatenate([x1 * cos - x2 * sin, x1 * sin + x2 * cos], axis=-1).astype(x.dtype)


def causal_block_attention(q, k, v, scale):
    B, H, S, dk = q.shape
    nq = S // Q_BLOCK
    qb = q.reshape(B, H, nq, Q_BLOCK, dk).transpose(2, 0, 1, 3, 4)
    k_pos = jnp.arange(S)

    def one(args):
        qi, i = args
        q_pos = i * Q_BLOCK + jnp.arange(Q_BLOCK)
        s = jnp.einsum('bhqd,bhkd->bhqk', qi, k).astype(jnp.float32) * scale
        s = jnp.where(k_pos[None, :] <= q_pos[:, None], s, -jnp.inf)
        p = jax.nn.softmax(s, axis=-1)
        return jnp.einsum('bhqk,bhkd->bhqd', p.astype(v.dtype), v)

    o = lax.map(one, (qb, jnp.arange(nq)))
    return o.transpose(1, 2, 0, 3, 4).reshape(B, H, S, v.shape[-1])


def mla_mixer(h, w_in, q_lat_norm, w_q_up, kv_lat_norm, w_kv_up, q_norm, k_norm):
    B, S, _ = h.shape
    proj = h @ w_in
    c1 = MLA_Q_RANK
    c2 = c1 + MLA_KV_RANK
    c3 = c2 + MLA_ROPE
    q_lat, kv_lat, k_rope, gate = proj[..., :c1], proj[..., c1:c2], proj[..., c2:c3], proj[..., c3:]
    q = (rms_norm(q_lat, q_lat_norm) @ w_q_up).reshape(B, S, N_HEADS, MLA_QK_DIM)
    kv = (rms_norm(kv_lat, kv_lat_norm) @ w_kv_up).reshape(B, S, N_HEADS, MLA_NOPE + MLA_V)
    k_nope, v = kv[..., :MLA_NOPE], kv[..., MLA_NOPE:]
    q = jnp.concatenate([rms_norm(q[..., :MLA_NOPE], q_norm[:MLA_NOPE]),
                         rope(rms_norm(q[..., MLA_NOPE:], q_norm[MLA_NOPE:]))], axis=-1)
    k_nope = rms_norm(k_nope, k_norm[:MLA_NOPE])
    k_rope = rope(rms_norm(k_rope, k_norm[MLA_NOPE:])[:, :, None, :])
    k = jnp.concatenate([k_nope, jnp.broadcast_to(k_rope, (B, S, N_HEADS, MLA_ROPE))], axis=-1)
    o = causal_block_attention(q.transpose(0, 2, 1, 3), k.transpose(0, 2, 1, 3),
                               v.transpose(0, 2, 1, 3), MLA_QK_DIM ** -0.5)
    return from_heads(o) * jax.nn.silu(gate)


def moba_attention(q, k, v, slopes):
    B, H, S, D = q.shape
    Sp = -(-S // MOBA_BLOCK) * MOBA_BLOCK
    pad = ((0, 0), (0, 0), (0, Sp - S), (0, 0))
    q, k, v = jnp.pad(q, pad), jnp.pad(k, pad), jnp.pad(v, pad)
    NB = Sp // MOBA_BLOCK
    kb = k.reshape(B, H, NB, MOBA_BLOCK, D)
    vb = v.reshape(B, H, NB, MOBA_BLOCK, D)
    k_mean = jnp.mean(kb.astype(jnp.float32), axis=3)
    score = jnp.einsum('bhsd,bhnd->bhsn', q.astype(jnp.float32), k_mean)
    q_blk = jnp.arange(Sp) // MOBA_BLOCK
    past = jnp.arange(NB)[None, :] < q_blk[:, None]
    score = jnp.where(past, score, -jnp.inf)
    kk = min(MOBA_TOPK, NB)
    top_val, top_idx = lax.top_k(score, kk)
    top_ok = top_val > -jnp.inf

    Cq = MOBA_Q_CHUNK
    nc = Sp // Cq
    qc = q.reshape(B, H, nc, Cq, D).transpose(2, 0, 1, 3, 4)
    ic = top_idx.reshape(B, H, nc, Cq, kk).transpose(2, 0, 1, 3, 4)
    okc = top_ok.reshape(B, H, nc, Cq, kk).transpose(2, 0, 1, 3, 4)
    bi = jnp.arange(B)[:, None, None, None]
    hi = jnp.arange(H)[None, :, None, None]
    sl = slopes[None, :, None, None]
    scale = D ** -0.5
    offs = jnp.arange(MOBA_BLOCK)

    def one(args):
        qi, idx, ok, c = args
        q_pos = c * Cq + jnp.arange(Cq)
        own = (c * Cq) // MOBA_BLOCK
        k_sel = kb[bi, hi, idx].reshape(B, H, Cq, kk * MOBA_BLOCK, D)
        v_sel = vb[bi, hi, idx].reshape(B, H, Cq, kk * MOBA_BLOCK, D)
        sel_pos = (idx[..., None] * MOBA_BLOCK + offs).reshape(B, H, Cq, kk * MOBA_BLOCK)
        sel_ok = jnp.repeat(ok, MOBA_BLOCK, axis=-1)
        d_sel = (q_pos[:, None] - sel_pos).astype(jnp.float32)
        s_sel = jnp.einsum('bhqd,bhqkd->bhqk', qi, k_sel).astype(jnp.float32) * scale - sl * d_sel
        s_sel = jnp.where(sel_ok, s_sel, -jnp.inf)
        k_own = lax.dynamic_index_in_dim(kb, own, axis=2, keepdims=False)
        v_own = lax.dynamic_index_in_dim(vb, own, axis=2, keepdims=False)
        d_own = q_pos[:, None] - (own * MOBA_BLOCK + offs)[None, :]
        s_own = jnp.einsum('bhqd,bhkd->bhqk', qi, k_own).astype(jnp.float32) * scale - sl * d_own.astype(jnp.float32)
        s_own = jnp.where(d_own >= 0, s_own, -jnp.inf)
        p = jax.nn.softmax(jnp.concatenate([s_sel, s_own], axis=-1), axis=-1).astype(v.dtype)
        n_sel = kk * MOBA_BLOCK
        return (jnp.einsum('bhqk,bhqkd->bhqd', p[..., :n_sel], v_sel)
                + jnp.einsum('bhqk,bhkd->bhqd', p[..., n_sel:], v_own))

    o = lax.map(one, (qc, ic, okc, jnp.arange(nc)))
    return o.transpose(1, 2, 0, 3, 4).reshape(B, H, Sp, D)[:, :, :S]


def moba_mixer(h, w_in, q_norm, k_norm):
    q, k, v, gate = jnp.split(h @ w_in, 4, axis=-1)
    q = rms_norm(to_heads(q, N_HEADS, HEAD_DIM), q_norm)
    k = rms_norm(to_heads(k, N_HEADS, HEAD_DIM), k_norm)
    v = to_heads(v, N_HEADS, HEAD_DIM)
    o = moba_attention(q, k, v, alibi_slopes())
    return from_heads(o) * jax.nn.silu(gate)


def stick_breaking_attention(q, k, v):
    B, H, S, D = q.shape
    nq = S // Q_BLOCK
    qb = q.reshape(B, H, nq, Q_BLOCK, D).transpose(2, 0, 1, 3, 4)
    k_pos = jnp.arange(S)
    scale = D ** -0.5

    def one(args):
        qi, i = args
        q_pos = i * Q_BLOCK + jnp.arange(Q_BLOCK)
        before = k_pos[None, :] < q_pos[:, None]
        z = jnp.einsum('bhqd,bhkd->bhqk', qi, k).astype(jnp.float32) * scale
        log_keep = jnp.where(before, jax.nn.log_sigmoid(-z), 0.0)
        log_between = lax.cumsum(log_keep, axis=3, reverse=True) - log_keep
        a = jnp.where(before, jnp.exp(jax.nn.log_sigmoid(z) + log_between), 0.0)
        return jnp.einsum('bhqk,bhkd->bhqd', a.astype(v.dtype), v)

    o = lax.map(one, (qb, jnp.arange(nq)))
    return o.transpose(1, 2, 0, 3, 4).reshape(B, H, S, D)


def stick_breaking_mixer(h, w_in):
    q, k, v, gate = jnp.split(h @ w_in, 4, axis=-1)
    o = stick_breaking_attention(to_heads(q, N_HEADS, HEAD_DIM), to_heads(k, N_HEADS, HEAD_DIM),
                                 to_heads(v, N_HEADS, HEAD_DIM))
    return from_heads(o) * jax.nn.silu(gate)


def nsa_compress(t, w, pos):
    S = t.shape[2]
    n_cmp = (S - NSA_CMP_BLOCK) // NSA_CMP_STRIDE + 1
    idx = np.arange(n_cmp)[:, None] * NSA_CMP_STRIDE + np.arange(NSA_CMP_BLOCK)[None, :]
    blocks = t[:, :, idx] + pos
    return blocks.reshape(blocks.shape[0], blocks.shape[1], n_cmp, -1) @ w


def nsa_compressed_branch(q, k_cmp, v_cmp, slopes):
    B, G, P, S, D = q.shape
    n_cmp = k_cmp.shape[2]
    n_sel = S // NSA_SEL_BLOCK
    kn = min(NSA_SEL_N, n_sel)
    cmp_end = jnp.arange(n_cmp) * NSA_CMP_STRIDE + NSA_CMP_BLOCK - 1
    c_start = np.arange(n_cmp)[:, None] * NSA_CMP_STRIDE
    s_start = np.arange(n_sel)[None, :] * NSA_SEL_BLOCK
    cmp_to_sel = jnp.asarray((c_start < s_start + NSA_SEL_BLOCK) & (c_start + NSA_CMP_BLOCK > s_start),
                             dtype=jnp.float32)
    sl = slopes[None, :, :, None, None]
    scale = D ** -0.5
    nq = S // Q_BLOCK
    qb = q.reshape(B, G, P, nq, Q_BLOCK, D).transpose(3, 0, 1, 2, 4, 5)
    blk_ids = jnp.arange(n_sel)

    def one(args):
        qi, i = args
        q_pos = i * Q_BLOCK + jnp.arange(Q_BLOCK)
        dist = q_pos[:, None] - cmp_end[None, :]
        mask = dist >= 0
        s = jnp.einsum('bgpqd,bgnd->bgpqn', qi, k_cmp).astype(jnp.float32) * scale - sl * dist.astype(jnp.float32)
        p = jax.nn.softmax(jnp.where(mask, s, NEG_BIG), axis=-1) * mask
        o = jnp.einsum('bgpqn,bgnd->bgpqd', p.astype(v_cmp.dtype), v_cmp)
        imp = jnp.einsum('bgpqn,nj->bgqj', p, cmp_to_sel)
        cur = (q_pos // NSA_SEL_BLOCK)[:, None]
        forced = (blk_ids == 0) | (blk_ids == cur) | (blk_ids == cur - 1)
        imp = jnp.where(blk_ids > cur, -jnp.inf, jnp.where(forced, jnp.inf, imp))
        val, idx = lax.top_k(imp, kn)
        return o, idx, val > -jnp.inf

    o, idx, ok = lax.map(one, (qb, jnp.arange(nq)))
    o = o.transpose(1, 2, 3, 0, 4, 5).reshape(B, G, P, S, D)
    idx = idx.transpose(1, 2, 0, 3, 4).reshape(B, G, S, kn)
    ok = ok.transpose(1, 2, 0, 3, 4).reshape(B, G, S, kn)
    return o, idx, ok


def nsa_selected_branch(q, k, v, sel_idx, sel_ok, slopes):
    B, G, P, S, D = q.shape
    n_sel = S // NSA_SEL_BLOCK
    kn = sel_idx.shape[-1]
    kb = k.reshape(B, G, n_sel, NSA_SEL_BLOCK, D)
    vb = v.reshape(B, G, n_sel, NSA_SEL_BLOCK, D)
    Cq = NSA_Q_CHUNK
    nc = S // Cq
    qc = q.reshape(B, G, P, nc, Cq, D).transpose(3, 0, 1, 2, 4, 5)
    ic = sel_idx.reshape(B, G, nc, Cq, kn).transpose(2, 0, 1, 3, 4)
    okc = sel_ok.reshape(B, G, nc, Cq, kn).transpose(2, 0, 1, 3, 4)
    bi = jnp.arange(B)[:, None, None, None]
    gi = jnp.arange(G)[None, :, None, None]
    sl = slopes[None, :, :, None, None]
    scale = D ** -0.5
    offs = jnp.arange(NSA_SEL_BLOCK)
    n_keys = kn * NSA_SEL_BLOCK

    def one(args):
        qi, idx, ok, c = args
        q_pos = c * Cq + jnp.arange(Cq)
        k_sel = kb[bi, gi, idx].reshape(B, G, Cq, n_keys, D)
        v_sel = vb[bi, gi, idx].reshape(B, G, Cq, n_keys, D)
        k_pos = (idx[..., None] * NSA_SEL_BLOCK + offs).reshape(B, G, Cq, n_keys)
        dist = q_pos[:, None] - k_pos
        mask = (dist >= 0) & jnp.repeat(ok, NSA_SEL_BLOCK, axis=-1)
        s = jnp.einsum('bgpqd,bgqkd->bgpqk', qi, k_sel).astype(jnp.float32) * scale - sl * dist[:, :, None].astype(jnp.float32)
        p = jax.nn.softmax(jnp.where(mask[:, :, None], s, -jnp.inf), axis=-1)
        return jnp.einsum('bgpqk,bgqkd->bgpqd', p.astype(v.dtype), v_sel)

    o = lax.map(one, (qc, ic, okc, jnp.arange(nc)))
    return o.transpose(1, 2, 3, 0, 4, 5).reshape(B, G, P, S, D)


def nsa_window_branch(q, k, v, slopes):
    B, G, P, S, D = q.shape
    W = NSA_WINDOW
    L = W + Q_BLOCK
    pad = ((0, 0), (0, 0), (W, 0), (0, 0))
    kp, vp = jnp.pad(k, pad), jnp.pad(v, pad)
    sl = slopes[None, :, :, None, None]
    scale = D ** -0.5
    nq = S // Q_BLOCK
    qb = q.reshape(B, G, P, nq, Q_BLOCK, D).transpose(3, 0, 1, 2, 4, 5)

    def one(args):
        qi, i = args
        qs = i * Q_BLOCK
        kw = lax.dynamic_slice_in_dim(kp, qs, L, axis=2)
        vw = lax.dynamic_slice_in_dim(vp, qs, L, axis=2)
        k_pos = qs - W + jnp.arange(L)
        q_pos = qs + jnp.arange(Q_BLOCK)
        dist = q_pos[:, None] - k_pos[None, :]
        mask = (dist >= 0) & (dist < W) & (k_pos[None, :] >= 0)
        s = jnp.einsum('bgpqd,bgkd->bgpqk', qi, kw).astype(jnp.float32) * scale - sl * dist.astype(jnp.float32)
        p = jax.nn.softmax(jnp.where(mask, s, -jnp.inf), axis=-1)
        return jnp.einsum('bgpqk,bgkd->bgpqd', p.astype(v.dtype), vw)

    o = lax.map(one, (qb, jnp.arange(nq)))
    return o.transpose(1, 2, 3, 0, 4, 5).reshape(B, G, P, S, D)


def nsa_mixer(h, w_in, q_norm, k_norm, w_cmp_k, w_cmp_v, cmp_pos):
    B, S, _ = h.shape
    G, P, D = NSA_GROUPS, NSA_HPG, HEAD_DIM
    cuts = np.cumsum([MIX_WIDTH, NSA_KV_WIDTH, NSA_KV_WIDTH, NSA_KV_WIDTH, 3 * N_HEADS]).tolist()
    q, kv_c, kv_s, kv_w, g_br, gate = jnp.split(h @ w_in, cuts, axis=-1)
    q = rms_norm(to_heads(q, N_HEADS, D), q_norm).reshape(B, G, P, S, D)

    def kv_split(t):
        kk, vv = jnp.split(t, 2, axis=-1)
        return to_heads(kk, G, D), to_heads(vv, G, D)

    kc, vc = kv_split(kv_c)
    k_cmp = rms_norm(nsa_compress(kc, w_cmp_k, cmp_pos), k_norm[0])
    v_cmp = nsa_compress(vc, w_cmp_v, cmp_pos)
    ks, vs = kv_split(kv_s)
    ks = rms_norm(ks, k_norm[1])
    kw, vw = kv_split(kv_w)
    kw = rms_norm(kw, k_norm[2])
    slopes = alibi_slopes().reshape(G, P)
    o_cmp, sel_idx, sel_ok = nsa_compressed_branch(q, k_cmp, v_cmp, slopes)
    o_slc = nsa_selected_branch(q, ks, vs, sel_idx, sel_ok, slopes)
    o_win = nsa_window_branch(q, kw, vw, slopes)
    g = jax.nn.sigmoid(g_br.astype(jnp.float32)).reshape(B, S, G, P, 3).transpose(4, 0, 2, 3, 1)[..., None]
    o = (g[0] * o_cmp + g[1] * o_slc + g[2] * o_win).astype(h.dtype)
    return from_heads(o.reshape(B, N_HEADS, S, D)) * jax.nn.silu(gate)


def setup_inputs(seed: int = 0) -> dict:
    key = jax.random.key(seed)
    keys = iter(jax.random.split(key, 32))

    def dense(shape, fan_in):
        return jax.random.normal(next(keys), shape, jnp.float32) * (fan_in ** -0.5)

    def gain(shape):
        return 1.0 + 0.02 * jax.random.normal(next(keys), shape, jnp.float32)

    na, nb, nc, nd = (layers_of(m) for m in range(N_MIXERS))
    D = D_MODEL
    cmp_in = NSA_CMP_BLOCK * HEAD_DIM
    return {
        'x': jax.random.normal(next(keys), (BATCH, SEQ, D), jnp.float32),
        'norm_a': gain((na, D)),
        'w_in_a': dense((na, D, MLA_IN), D),
        'q_lat_norm_a': gain((na, MLA_Q_RANK)),
        'w_q_up_a': dense((na, MLA_Q_RANK, N_HEADS * MLA_QK_DIM), MLA_Q_RANK),
        'kv_lat_norm_a': gain((na, MLA_KV_RANK)),
        'w_kv_up_a': dense((na, MLA_KV_RANK, N_HEADS * (MLA_NOPE + MLA_V)), MLA_KV_RANK),
        'q_norm_a': gain((na, MLA_QK_DIM)),
        'k_norm_a': gain((na, MLA_QK_DIM)),
        'w_out_a': dense((na, MIX_WIDTH, D), MIX_WIDTH),
        'norm_b': gain((nb, D)),
        'w_in_b': dense((nb, D, QKV_GATE_IN), D),
        'q_norm_b': gain((nb, HEAD_DIM)),
        'k_norm_b': gain((nb, HEAD_DIM)),
        'w_out_b': dense((nb, MIX_WIDTH, D), MIX_WIDTH),
        'norm_c': gain((nc, D)),
        'w_in_c': dense((nc, D, QKV_GATE_IN), D),
        'w_out_c': dense((nc, MIX_WIDTH, D), MIX_WIDTH),
        'norm_d': gain((nd, D)),
        'w_in_d': dense((nd, D, NSA_IN), D),
        'q_norm_d': gain((nd, HEAD_DIM)),
        'k_norm_d': gain((nd, 3, HEAD_DIM)),
        'w_cmp_k_d': dense((nd, cmp_in, HEAD_DIM), cmp_in),
        'w_cmp_v_d': dense((nd, cmp_in, HEAD_DIM), cmp_in),
        'cmp_pos_d': 0.1 * jax.random.normal(next(keys), (nd, NSA_CMP_BLOCK, HEAD_DIM), jnp.float32),
        'w_out_d': dense((nd, MIX_WIDTH, D), MIX_WIDTH),
    }


def reference(x, norm_a, w_in_a, q_lat_norm_a, w_q_up_a, kv_lat_norm_a, w_kv_up_a, q_norm_a, k_norm_a, w_out_a,
              norm_b, w_in_b, q_norm_b, k_norm_b, w_out_b,
              norm_c, w_in_c, w_out_c,
              norm_d, w_in_d, q_norm_d, k_norm_d, w_cmp_k_d, w_cmp_v_d, cmp_pos_d, w_out_d):
    for i in range(DEPTH):
        m, j = i % N_MIXERS, i // N_MIXERS
        if m == 0:
            y = mla_mixer(rms_norm(x, norm_a[j]), w_in_a[j], q_lat_norm_a[j], w_q_up_a[j],
                          kv_lat_norm_a[j], w_kv_up_a[j], q_norm_a[j], k_norm_a[j]) @ w_out_a[j]
        elif m == 1:
            y = moba_mixer(rms_norm(x, norm_b[j]), w_in_b[j], q_norm_b[j], k_norm_b[j]) @ w_out_b[j]
        elif m == 2:
            y = stick_breaking_mixer(rms_norm(x, norm_c[j]), w_in_c[j]) @ w_out_c[j]
        else:
            y = nsa_mixer(rms_norm(x, norm_d[j]), w_in_d[j], q_norm_d[j], k_norm_d[j],
                          w_cmp_k_d[j], w_cmp_v_d[j], cmp_pos_d[j]) @ w_out_d[j]
        x = x + y
    return x
```

```cpp
#include <hip/hip_runtime.h>
#include <stdint.h>
#include <math.h>

typedef unsigned short bf16_t;
typedef float f32x4 __attribute__((ext_vector_type(4)));
typedef unsigned u32x4 __attribute__((ext_vector_type(4)));

#define SEQ 8192
#define DM 2048
#define NH 16
#define HD 128

__device__ __forceinline__ bf16_t f2bf(float f) { unsigned u = __float_as_uint(f); u += 0x7fffu + ((u >> 16) & 1u); return (bf16_t)(u >> 16); }
__device__ __forceinline__ float bf2f(bf16_t h) { return __uint_as_float(((unsigned)h) << 16); }
__device__ __forceinline__ float wave_sum(float v) { for (int o = 32; o > 0; o >>= 1) v += __shfl_xor(v, o); return v; }
__device__ __forceinline__ float wave_max(float v) { for (int o = 32; o > 0; o >>= 1) v = fmaxf(v, __shfl_xor(v, o)); return v; }
__device__ __forceinline__ float silu_f(float x) { return x / (1.f + __expf(-x)); }
__device__ __forceinline__ float sigmoid_f(float x) { return 1.f / (1.f + __expf(-x)); }
__device__ __forceinline__ float alibi_slope(int h) { return exp2f(-0.5f * (float)(h + 1)); }
__device__ __forceinline__ float logsig(float x) { return fminf(x, 0.f) - log1pf(__expf(-fabsf(x))); }

constexpr size_t WS_BAR = 0;
constexpr size_t WS_ROPE = 16384;
constexpr size_t WS_H = WS_ROPE + (size_t)SEQ * 64 * 4;
constexpr size_t WS_AO = WS_H + (size_t)SEQ * DM * 2;
constexpr size_t WS_SMALL = WS_AO + (size_t)SEQ * DM * 2;
constexpr size_t WS_QL = WS_SMALL;
constexpr size_t WS_KVL = WS_QL + (size_t)SEQ * 512 * 2;
constexpr size_t WS_KR = WS_KVL + (size_t)SEQ * 256 * 2;
constexpr size_t WS_KMEAN = WS_KR + (size_t)SEQ * 64 * 2;
constexpr size_t WS_KCMP = WS_KMEAN + (size_t)16 * 32 * 128 * 4;
constexpr size_t WS_VCMP = WS_KCMP + (size_t)4 * 512 * 128 * 4;
constexpr size_t WS_ARENA = WS_VCMP + (size_t)4 * 512 * 128 * 4;
constexpr size_t AR_PB = 0;
constexpr size_t AR_QU = (size_t)SEQ * 3072 * 2;
constexpr size_t AR_KVU = AR_QU + (size_t)SEQ * 3072 * 2;
constexpr size_t WS_END = WS_ARENA + AR_KVU + (size_t)SEQ * 4096 * 2;

__global__ void nk_rope_table(float* tab) {
    int idx = blockIdx.x * blockDim.x + threadIdx.x;
    if (idx >= SEQ * 32) return;
    int pos = idx >> 5, i = idx & 31;
    float inv = powf(10000.f, -(float)(2 * i) / 64.f);
    float ang = (float)pos * inv;
    double a = (double)ang;
    tab[idx * 2 + 0] = (float)cos(a);
    tab[idx * 2 + 1] = (float)sin(a);
}

__global__ __launch_bounds__(256) void nk_rmsnorm(const float* __restrict__ x, const float* __restrict__ g, bf16_t* __restrict__ out) {
    __shared__ float red[4];
    const int row = blockIdx.x, t = threadIdx.x;
    const float* xr = x + (size_t)row * DM;
    float v[8]; float ss = 0.f;
    for (int i = 0; i < 8; ++i) { v[i] = xr[t + i * 256]; ss += v[i] * v[i]; }
    ss = wave_sum(ss);
    if ((t & 63) == 0) red[t >> 6] = ss;
    __syncthreads();
    float tot = red[0] + red[1] + red[2] + red[3];
    float rinv = rsqrtf(tot / (float)DM + 1e-6f);
    for (int i = 0; i < 8; ++i) out[(size_t)row * DM + t + i * 256] = f2bf(v[i] * rinv * g[t + i * 256]);
}

template <int MODE>
__global__ __launch_bounds__(256) void nk_gemm(const bf16_t* __restrict__ A, int lda, const float* __restrict__ W, int ldw, int K, int N,
                                               void* C, int ldc, const float* res) {
    __shared__ float As[16][64];
    __shared__ float Ws[16][64];
    const int bm = blockIdx.y * 64, bn = blockIdx.x * 64;
    const int t = threadIdx.x, tx = t & 15, ty = t >> 4;
    float acc[4][4];
    for (int i = 0; i < 4; ++i) for (int j = 0; j < 4; ++j) acc[i][j] = 0.f;
    const int ar = t >> 2, ak = (t & 3) * 4;
    const int wk = t >> 4, wc = (t & 15) * 4;
    for (int k0 = 0; k0 < K; k0 += 16) {
        const bf16_t* ap = A + (size_t)(bm + ar) * lda + k0 + ak;
        for (int i = 0; i < 4; ++i) As[ak + i][ar] = bf2f(ap[i]);
        const float* wp = W + (size_t)(k0 + wk) * ldw + bn + wc;
        for (int i = 0; i < 4; ++i) Ws[wk][wc + i] = (bn + wc + i < N) ? wp[i] : 0.f;
        __syncthreads();
#pragma unroll
        for (int kk = 0; kk < 16; ++kk) {
            float a[4], b[4];
            for (int i = 0; i < 4; ++i) a[i] = As[kk][ty * 4 + i];
            for (int j = 0; j < 4; ++j) b[j] = Ws[kk][tx * 4 + j];
            for (int i = 0; i < 4; ++i) for (int j = 0; j < 4; ++j) acc[i][j] += a[i] * b[j];
        }
        __syncthreads();
    }
    for (int i = 0; i < 4; ++i) for (int j = 0; j < 4; ++j) {
        const int r = bm + ty * 4 + i, c = bn + tx * 4 + j;
        if (c < N) {
            if (MODE == 0) ((bf16_t*)C)[(size_t)r * ldc + c] = f2bf(acc[i][j]);
            else ((float*)C)[(size_t)r * ldc + c] = res[(size_t)r * ldc + c] + acc[i][j];
        }
    }
}

__global__ __launch_bounds__(192) void nk_mla_prep1(const bf16_t* __restrict__ PB, const float* __restrict__ qln, const float* __restrict__ kvln,
                                                    const float* __restrict__ knorm, const float* __restrict__ rope,
                                                    bf16_t* __restrict__ QL, bf16_t* __restrict__ KVL, bf16_t* __restrict__ KR) {
    const int tok = blockIdx.x, w = threadIdx.x >> 6, lane = threadIdx.x & 63;
    const bf16_t* p = PB + (size_t)tok * 3072;
    if (w == 0) {
        float v[8], ss = 0.f;
        for (int i = 0; i < 8; ++i) { v[i] = bf2f(p[lane + i * 64]); ss += v[i] * v[i]; }
        ss = wave_sum(ss); float r = rsqrtf(ss / 512.f + 1e-6f);
        for (int i = 0; i < 8; ++i) QL[(size_t)tok * 512 + lane + i * 64] = f2bf(v[i] * r * qln[lane + i * 64]);
    } else if (w == 1) {
        float v[4], ss = 0.f;
        for (int i = 0; i < 4; ++i) { v[i] = bf2f(p[512 + lane + i * 64]); ss += v[i] * v[i]; }
        ss = wave_sum(ss); float r = rsqrtf(ss / 256.f + 1e-6f);
        for (int i = 0; i < 4; ++i) KVL[(size_t)tok * 256 + lane + i * 64] = f2bf(v[i] * r * kvln[lane + i * 64]);
    } else {
        float v = bf2f(p[768 + lane]); float ss = wave_sum(v * v); float r = rsqrtf(ss / 64.f + 1e-6f);
        v = v * r * knorm[128 + lane];
        float other = __shfl_xor(v, 32);
        const int i = lane & 31; const float c = rope[((size_t)tok * 32 + i) * 2], s = rope[((size_t)tok * 32 + i) * 2 + 1];
        float o = (lane < 32) ? (v * c - other * s) : (other * s + v * c);
        KR[(size_t)tok * 64 + lane] = f2bf(o);
    }
}
__global__ __launch_bounds__(256) void nk_mla_prep2(bf16_t* __restrict__ QU, bf16_t* __restrict__ KVU, const float* __restrict__ qnorm,
                                                    const float* __restrict__ knorm, const float* __restrict__ rope) {
    const int gw = blockIdx.x * 4 + (threadIdx.x >> 6), lane = threadIdx.x & 63;
    const int tok = gw >> 4, h = gw & 15;
    bf16_t* q = QU + (size_t)tok * 3072 + h * 192;
    float a0 = bf2f(q[lane]), a1 = bf2f(q[lane + 64]);
    float ss = wave_sum(a0 * a0 + a1 * a1); float r = rsqrtf(ss / 128.f + 1e-6f);
    q[lane] = f2bf(a0 * r * qnorm[lane]); q[lane + 64] = f2bf(a1 * r * qnorm[lane + 64]);
    float v = bf2f(q[128 + lane]); float s2 = wave_sum(v * v); float r2 = rsqrtf(s2 / 64.f + 1e-6f);
    v = v * r2 * qnorm[128 + lane];
    float other = __shfl_xor(v, 32);
    const int i = lane & 31; const float c = rope[((size_t)tok * 32 + i) * 2], s = rope[((size_t)tok * 32 + i) * 2 + 1];
    float o = (lane < 32) ? (v * c - other * s) : (other * s + v * c);
    q[128 + lane] = f2bf(o);
    bf16_t* k = KVU + (size_t)tok * 4096 + h * 256;
    float b0 = bf2f(k[lane]), b1 = bf2f(k[lane + 64]);
    float s3 = wave_sum(b0 * b0 + b1 * b1); float r3 = rsqrtf(s3 / 128.f + 1e-6f);
    k[lane] = f2bf(b0 * r3 * knorm[lane]); k[lane + 64] = f2bf(b1 * r3 * knorm[lane + 64]);
}

__device__ __forceinline__ float dot_row(const float* q, const bf16_t* k, int n) {
    float s = 0.f;
    for (int i = 0; i < n; i += 8) {
        u32x4 w = *(const u32x4*)(k + i);
        s += q[i + 0] * __uint_as_float(w.x << 16) + q[i + 1] * __uint_as_float(w.x & 0xffff0000u);
        s += q[i + 2] * __uint_as_float(w.y << 16) + q[i + 3] * __uint_as_float(w.y & 0xffff0000u);
        s += q[i + 4] * __uint_as_float(w.z << 16) + q[i + 5] * __uint_as_float(w.z & 0xffff0000u);
        s += q[i + 6] * __uint_as_float(w.w << 16) + q[i + 7] * __uint_as_float(w.w & 0xffff0000u);
    }
    return s;
}
struct SoftAcc { float m, l, o0, o1; };
__device__ __forceinline__ void soft_tile(SoftAcc& a, float s, int key, const bf16_t* vbase, size_t vstride, int lane) {
    float tm = wave_max(s);
    if (tm == -INFINITY) return;
    float mn = fmaxf(a.m, tm);
    float alpha = __expf(a.m - mn);
    float p = (s == -INFINITY) ? 0.f : __expf(s - mn);
    a.l = a.l * alpha + wave_sum(p);
    a.o0 *= alpha; a.o1 *= alpha; a.m = mn;
    for (int j = 0; j < 64; ++j) {
        float pj = __shfl(p, j); int kj = __shfl(key, j);
        if (pj != 0.f) {
            unsigned w = *(const unsigned*)(vbase + (size_t)kj * vstride + 2 * lane);
            a.o0 += pj * __uint_as_float(w << 16); a.o1 += pj * __uint_as_float(w & 0xffff0000u);
        }
    }
}

__global__ __launch_bounds__(256) void nk_attn_mla(const bf16_t* __restrict__ QU, const bf16_t* __restrict__ KVU, const bf16_t* __restrict__ KR,
                                                   const bf16_t* __restrict__ PB, bf16_t* __restrict__ AO) {
    __shared__ float qs[4][192];
    const int w = threadIdx.x >> 6, lane = threadIdx.x & 63;
    const int h = blockIdx.y, tok = blockIdx.x * 4 + w;
    const bf16_t* q = QU + (size_t)tok * 3072 + h * 192;
    for (int i = lane; i < 192; i += 64) qs[w][i] = bf2f(q[i]);
    __syncthreads();
    const float scale = 0.07216878364870322f;
    SoftAcc a{-INFINITY, 0.f, 0.f, 0.f};
    for (int k0 = 0; k0 <= tok; k0 += 64) {
        int key = k0 + lane; float s = -INFINITY;
        if (key <= tok) {
            s = dot_row(qs[w], KVU + (size_t)key * 4096 + h * 256, 128) + dot_row(qs[w] + 128, KR + (size_t)key * 64, 64);
            s *= scale;
        }
        soft_tile(a, s, key, KVU + h * 256 + 128, 4096, lane);
    }
    const float il = 1.f / a.l;
    const bf16_t* g = PB + (size_t)tok * 3072 + 832 + h * 128;
    unsigned gw = *(const unsigned*)(g + 2 * lane);
    float g0 = __uint_as_float(gw << 16), g1 = __uint_as_float(gw & 0xffff0000u);
    AO[(size_t)tok * DM + h * 128 + 2 * lane] = f2bf(a.o0 * il * silu_f(g0));
    AO[(size_t)tok * DM + h * 128 + 2 * lane + 1] = f2bf(a.o1 * il * silu_f(g1));
}

__global__ __launch_bounds__(256) void nk_headnorm(bf16_t* __restrict__ PB, int ld, int col0, int nheads, const float* __restrict__ g) {
    const int gw = blockIdx.x * 4 + (threadIdx.x >> 6), lane = threadIdx.x & 63;
    const int tok = gw / nheads, h = gw % nheads;
    bf16_t* p = PB + (size_t)tok * ld + col0 + h * 128;
    float a0 = bf2f(p[lane]), a1 = bf2f(p[lane + 64]);
    float ss = wave_sum(a0 * a0 + a1 * a1); float r = rsqrtf(ss / 128.f + 1e-6f);
    p[lane] = f2bf(a0 * r * g[lane]); p[lane + 64] = f2bf(a1 * r * g[lane + 64]);
}
__global__ __launch_bounds__(128) void nk_kmean(const bf16_t* __restrict__ PB, float* __restrict__ kmean) {
    const int n = blockIdx.x, h = blockIdx.y, d = threadIdx.x;
    float s = 0.f;
    for (int i = 0; i < 256; ++i) s += bf2f(PB[(size_t)(n * 256 + i) * 8192 + 2048 + h * 128 + d]);
    kmean[((size_t)h * 32 + n) * 128 + d] = s * (1.f / 256.f);
}
__global__ __launch_bounds__(256) void nk_attn_moba(const bf16_t* __restrict__ PB, const float* __restrict__ kmean, bf16_t* __restrict__ AO) {
    __shared__ float qs[4][128];
    const int w = threadIdx.x >> 6, lane = threadIdx.x & 63;
    const int h = blockIdx.y, tok = blockIdx.x * 4 + w;
    const bf16_t* q = PB + (size_t)tok * 8192 + h * 128;
    for (int i = lane; i < 128; i += 64) qs[w][i] = bf2f(q[i]);
    __syncthreads();
    const int own = tok >> 8;
    float sc = -INFINITY;
    if (lane < own) { const float* km = kmean + ((size_t)h * 32 + lane) * 128; float s = 0.f; for (int d = 0; d < 128; ++d) s += qs[w][d] * km[d]; sc = s; }
    int sel[3]; bool ok[3];
    for (int r = 0; r < 3; ++r) {
        float mx = wave_max(sc);
        unsigned long long bal = __ballot(sc == mx);
        int idx = __ffsll((long long)bal) - 1;
        sel[r] = idx; ok[r] = (mx > -INFINITY);
        if (lane == idx) sc = -INFINITY;
        if (!ok[r]) sel[r] = 0;
    }
    const float scale = 0.08838834764831845f, slope = alibi_slope(h);
    const bf16_t* kb = PB + 2048 + h * 128; const bf16_t* vb = PB + 4096 + h * 128;
    SoftAcc a{-INFINITY, 0.f, 0.f, 0.f};
    for (int r = 0; r < 3; ++r) if (ok[r]) {
        for (int k0 = sel[r] * 256; k0 < sel[r] * 256 + 256; k0 += 64) {
            int key = k0 + lane;
            float s = dot_row(qs[w], kb + (size_t)key * 8192, 128) * scale - slope * (float)(tok - key);
            soft_tile(a, s, key, vb, 8192, lane);
        }
    }
    for (int k0 = own * 256; k0 <= tok; k0 += 64) {
        int key = k0 + lane; float s = -INFINITY;
        if (key <= tok) s = dot_row(qs[w], kb + (size_t)key * 8192, 128) * scale - slope * (float)(tok - key);
        soft_tile(a, s, key, vb, 8192, lane);
    }
    const float il = 1.f / a.l;
    unsigned gw = *(const unsigned*)(PB + (size_t)tok * 8192 + 6144 + h * 128 + 2 * lane);
    float g0 = __uint_as_float(gw << 16), g1 = __uint_as_float(gw & 0xffff0000u);
    AO[(size_t)tok * DM + h * 128 + 2 * lane] = f2bf(a.o0 * il * silu_f(g0));
    AO[(size_t)tok * DM + h * 128 + 2 * lane + 1] = f2bf(a.o1 * il * silu_f(g1));
}

__global__ __launch_bounds__(256) void nk_attn_sb(const bf16_t* __restrict__ PB, bf16_t* __restrict__ AO) {
    __shared__ float qs[4][128];
    const int w = threadIdx.x >> 6, lane = threadIdx.x & 63;
    const int h = blockIdx.y, tok = blockIdx.x * 4 + w;
    const bf16_t* q = PB + (size_t)tok * 8192 + h * 128;
    for (int i = lane; i < 128; i += 64) qs[w][i] = bf2f(q[i]);
    __syncthreads();
    const float scale = 0.08838834764831845f;
    const bf16_t* kb = PB + 2048 + h * 128; const bf16_t* vb = PB + 4096 + h * 128;
    float carry = 0.f, o0 = 0.f, o1 = 0.f;
    for (int j0 = 0; j0 < tok; j0 += 64) {
        int j = j0 + lane; int key = tok - 1 - j; bool valid = key >= 0;
        float z = 0.f;
        if (valid) z = dot_row(qs[w], kb + (size_t)key * 8192, 128) * scale;
        float lk = valid ? logsig(-z) : 0.f;
        float incl = lk;
        for (int o = 1; o < 64; o <<= 1) { float t = __shfl_up(incl, o); if (lane >= o) incl += t; }
        float excl = incl - lk;
        float a = valid ? __expf(logsig(z) + carry + excl) : 0.f;
        carry += __shfl(incl, 63);
        for (int jj = 0; jj < 64; ++jj) {
            float pj = __shfl(a, jj); int kj = __shfl(key, jj);
            if (pj != 0.f) {
                unsigned wv = *(const unsigned*)(vb + (size_t)kj * 8192 + 2 * lane);
                o0 += pj * __uint_as_float(wv << 16); o1 += pj * __uint_as_float(wv & 0xffff0000u);
            }
        }
        if (carry < -110.f) break;
    }
    unsigned gw = *(const unsigned*)(PB + (size_t)tok * 8192 + 6144 + h * 128 + 2 * lane);
    float g0 = __uint_as_float(gw << 16), g1 = __uint_as_float(gw & 0xffff0000u);
    AO[(size_t)tok * DM + h * 128 + 2 * lane] = f2bf(o0 * silu_f(g0));
    AO[(size_t)tok * DM + h * 128 + 2 * lane + 1] = f2bf(o1 * silu_f(g1));
}

#define LD3 7424
__global__ __launch_bounds__(128) void nk_nsa_compress(const bf16_t* __restrict__ PB, int col0, const float* __restrict__ Wc, const float* __restrict__ pos,
                                                       const float* __restrict__ gain, float* __restrict__ out) {
    __shared__ float blk[4096];
    __shared__ float red[2];
    const int n = blockIdx.x, g = blockIdx.y, c = threadIdx.x;
    for (int i = c; i < 4096; i += 128) { int l = i >> 7, d = i & 127; blk[i] = bf2f(PB[(size_t)(16 * n + l) * LD3 + col0 + g * 128 + d]) + pos[i]; }
    __syncthreads();
    float acc = 0.f;
    for (int k = 0; k < 4096; ++k) acc += blk[k] * Wc[(size_t)k * 128 + c];
    if (gain) {
        float ss = wave_sum(acc * acc);
        if ((c & 63) == 0) red[c >> 6] = ss;
        __syncthreads();
        float r = rsqrtf((red[0] + red[1]) / 128.f + 1e-6f);
        acc = acc * r * gain[c];
    }
    out[((size_t)g * 512 + n) * 128 + c] = acc;
}
__device__ __forceinline__ float dot_row_f32(const float* q, const float* k, int n) { float s = 0.f; for (int i = 0; i < n; ++i) s += q[i] * k[i]; return s; }
__global__ __launch_bounds__(256) void nk_attn_nsa(const bf16_t* __restrict__ PB, const float* __restrict__ kcmp, const float* __restrict__ vcmp,
                                                   bf16_t* __restrict__ AO) {
    __shared__ float qs[4][128];
    __shared__ float sc[4][512];
    __shared__ float Psum[512];
    __shared__ float imp[128];
    __shared__ int selidx[16];
    __shared__ int selok[16];
    const int w = threadIdx.x >> 6, lane = threadIdx.x & 63;
    const int tok = blockIdx.x, g = blockIdx.y, h = g * 4 + w;
    const bf16_t* row = PB + (size_t)tok * LD3;
    for (int i = lane; i < 128; i += 64) qs[w][i] = bf2f(row[h * 128 + i]);
    for (int i = threadIdx.x; i < 512; i += 256) Psum[i] = 0.f;
    __syncthreads();
    const float scale = 0.08838834764831845f, slope = alibi_slope(h);
    const int ncv = (tok >= 31) ? ((tok - 31) / 16 + 1) : 0;
    float oc0 = 0.f, oc1 = 0.f;
    if (ncv > 0) {
        float mx = -INFINITY;
        for (int n = lane; n < ncv; n += 64) {
            float s = dot_row_f32(qs[w], kcmp + ((size_t)g * 512 + n) * 128, 128) * scale - slope * (float)(tok - (16 * n + 31));
            sc[w][n] = s; mx = fmaxf(mx, s);
        }
        mx = wave_max(mx);
        float l = 0.f;
        for (int n = lane; n < ncv; n += 64) { float p = __expf(sc[w][n] - mx); sc[w][n] = p; l += p; }
        l = wave_sum(l);
        const float il = 1.f / l;
        for (int n = lane; n < ncv; n += 64) { float p = sc[w][n] * il; sc[w][n] = p; atomicAdd(&Psum[n], p); }
        __builtin_amdgcn_s_waitcnt(0);
        for (int n = 0; n < ncv; ++n) {
            float p = sc[w][n];
            const float* v = vcmp + ((size_t)g * 512 + n) * 128 + 2 * lane;
            oc0 += p * v[0]; oc1 += p * v[1];
        }
    }
    __syncthreads();
    const int cur = tok >> 6;
    if (threadIdx.x < 128) {
        int j = threadIdx.x; float s = 0.f;
        for (int i = 4 * j - 1; i <= 4 * j + 3; ++i) if (i >= 0 && i < 511) s += Psum[i];
        bool forced = (j == 0) || (j == cur) || (j == cur - 1);
        imp[j] = (j > cur) ? -INFINITY : (forced ? INFINITY : s);
    }
    __syncthreads();
    if (w == 0) {
        float v0 = imp[lane], v1 = imp[lane + 64];
        for (int r = 0; r < 16; ++r) {
            float mx = wave_max(fmaxf(v0, v1));
            unsigned long long b0 = __ballot(v0 == mx), b1 = __ballot(v1 == mx);
            int idx = b0 ? (__ffsll((long long)b0) - 1) : (64 + __ffsll((long long)b1) - 1);
            if (lane == 0) { selidx[r] = idx; selok[r] = (mx > -INFINITY) ? 1 : 0; }
            if (idx < 64) { if (lane == idx) v0 = -INFINITY; } else { if (lane == idx - 64) v1 = -INFINITY; }
        }
    }
    __syncthreads();
    const bf16_t* ksb = PB + 3072 + g * 128; const bf16_t* vsb = PB + 3584 + g * 128;
    SoftAcc as{-INFINITY, 0.f, 0.f, 0.f};
    for (int r = 0; r < 16; ++r) if (selok[r]) {
        int key = selidx[r] * 64 + lane; float s = -INFINITY;
        if (key <= tok) s = dot_row(qs[w], ksb + (size_t)key * LD3, 128) * scale - slope * (float)(tok - key);
        soft_tile(as, s, key, vsb, LD3, lane);
    }
    const bf16_t* kwb = PB + 4096 + g * 128; const bf16_t* vwb = PB + 4608 + g * 128;
    SoftAcc aw{-INFINITY, 0.f, 0.f, 0.f};
    int kstart = tok - 511; if (kstart < 0) kstart = 0;
    for (int k0 = kstart; k0 <= tok; k0 += 64) {
        int key = k0 + lane; float s = -INFINITY;
        if (key <= tok) s = dot_row(qs[w], kwb + (size_t)key * LD3, 128) * scale - slope * (float)(tok - key);
        soft_tile(aw, s, key, vwb, LD3, lane);
    }
    const bf16_t* gb = row + 5120 + h * 3;
    const float g0 = sigmoid_f(bf2f(gb[0])), g1 = sigmoid_f(bf2f(gb[1])), g2 = sigmoid_f(bf2f(gb[2]));
    const float ils = 1.f / as.l, ilw = 1.f / aw.l;
    float o0 = g0 * oc0 + g1 * as.o0 * ils + g2 * aw.o0 * ilw;
    float o1 = g0 * oc1 + g1 * as.o1 * ils + g2 * aw.o1 * ilw;
    unsigned gw = *(const unsigned*)(row + 5168 + h * 128 + 2 * lane);
    float ga = __uint_as_float(gw << 16), gb2 = __uint_as_float(gw & 0xffff0000u);
    AO[(size_t)tok * DM + h * 128 + 2 * lane] = f2bf(o0 * silu_f(ga));
    AO[(size_t)tok * DM + h * 128 + 2 * lane + 1] = f2bf(o1 * silu_f(gb2));
}

extern "C" void kernel_launch(void* const* d_in, const int* in_sizes, int n_in, void* d_out, int out_size, void* d_ws, size_t ws_size, hipStream_t stream) {
    if (ws_size < WS_END) return;
    const float* x = (const float*)d_in[0];
    const float* norm_a = (const float*)d_in[1];  const float* w_in_a = (const float*)d_in[2];  const float* q_lat_norm = (const float*)d_in[3];
    const float* w_q_up = (const float*)d_in[4];  const float* kv_lat_norm = (const float*)d_in[5]; const float* w_kv_up = (const float*)d_in[6];
    const float* q_norm_a = (const float*)d_in[7]; const float* k_norm_a = (const float*)d_in[8]; const float* w_out_a = (const float*)d_in[9];
    const float* norm_b = (const float*)d_in[10]; const float* w_in_b = (const float*)d_in[11]; const float* q_norm_b = (const float*)d_in[12];
    const float* k_norm_b = (const float*)d_in[13]; const float* w_out_b = (const float*)d_in[14];
    const float* norm_c = (const float*)d_in[15]; const float* w_in_c = (const float*)d_in[16]; const float* w_out_c = (const float*)d_in[17];
    const float* norm_d = (const float*)d_in[18]; const float* w_in_d = (const float*)d_in[19]; const float* q_norm_d = (const float*)d_in[20];
    const float* k_norm_d = (const float*)d_in[21]; const float* w_cmp_k = (const float*)d_in[22]; const float* w_cmp_v = (const float*)d_in[23];
    const float* cmp_pos = (const float*)d_in[24]; const float* w_out_d = (const float*)d_in[25];
    float* out = (float*)d_out;
    char* ws = (char*)d_ws;
    float* rope = (float*)(ws + WS_ROPE);
    bf16_t* H = (bf16_t*)(ws + WS_H); bf16_t* AO = (bf16_t*)(ws + WS_AO);
    bf16_t* QL = (bf16_t*)(ws + WS_QL); bf16_t* KVL = (bf16_t*)(ws + WS_KVL); bf16_t* KR = (bf16_t*)(ws + WS_KR);
    float* KMEAN = (float*)(ws + WS_KMEAN); float* KCMP = (float*)(ws + WS_KCMP); float* VCMP = (float*)(ws + WS_VCMP);
    bf16_t* PB = (bf16_t*)(ws + WS_ARENA + AR_PB); bf16_t* QU = (bf16_t*)(ws + WS_ARENA + AR_QU); bf16_t* KVU = (bf16_t*)(ws + WS_ARENA + AR_KVU);

    hipLaunchKernelGGL(nk_rope_table, dim3(SEQ * 32 / 256), dim3(256), 0, stream, rope);
    hipLaunchKernelGGL(nk_rmsnorm, dim3(SEQ), dim3(256), 0, stream, x, norm_a, H);
    hipLaunchKernelGGL(nk_gemm<0>, dim3(2880 / 64, SEQ / 64), dim3(256), 0, stream, H, DM, w_in_a, 2880, DM, 2880, (void*)PB, 3072, (const float*)nullptr);
    hipLaunchKernelGGL(nk_mla_prep1, dim3(SEQ), dim3(192), 0, stream, PB, q_lat_norm, kv_lat_norm, k_norm_a, rope, QL, KVL, KR);
    hipLaunchKernelGGL(nk_gemm<0>, dim3(3072 / 64, SEQ / 64), dim3(256), 0, stream, QL, 512, w_q_up, 3072, 512, 3072, (void*)QU, 3072, (const float*)nullptr);
    hipLaunchKernelGGL(nk_gemm<0>, dim3(4096 / 64, SEQ / 64), dim3(256), 0, stream, KVL, 256, w_kv_up, 4096, 256, 4096, (void*)KVU, 4096, (const float*)nullptr);
    hipLaunchKernelGGL(nk_mla_prep2, dim3(SEQ * 16 / 4), dim3(256), 0, stream, QU, KVU, q_norm_a, k_norm_a, rope);
    hipLaunchKernelGGL(nk_attn_mla, dim3(SEQ / 4, NH), dim3(256), 0, stream, QU, KVU, KR, PB, AO);
    hipLaunchKernelGGL(nk_gemm<1>, dim3(DM / 64, SEQ / 64), dim3(256), 0, stream, AO, DM, w_out_a, DM, DM, DM, (void*)out, DM, x);
    hipLaunchKernelGGL(nk_rmsnorm, dim3(SEQ), dim3(256), 0, stream, out, norm_b, H);
    hipLaunchKernelGGL(nk_gemm<0>, dim3(8192 / 64, SEQ / 64), dim3(256), 0, stream, H, DM, w_in_b, 8192, DM, 8192, (void*)PB, 8192, (const float*)nullptr);
    hipLaunchKernelGGL(nk_headnorm, dim3(SEQ * 16 / 4), dim3(256), 0, stream, PB, 8192, 0, 16, q_norm_b);
    hipLaunchKernelGGL(nk_headnorm, dim3(SEQ * 16 / 4), dim3(256), 0, stream, PB, 8192, 2048, 16, k_norm_b);
    hipLaunchKernelGGL(nk_kmean, dim3(32, NH), dim3(128), 0, stream, PB, KMEAN);
    hipLaunchKernelGGL(nk_attn_moba, dim3(SEQ / 4, NH), dim3(256), 0, stream, PB, KMEAN, AO);
    hipLaunchKernelGGL(nk_gemm<1>, dim3(DM / 64, SEQ / 64), dim3(256), 0, stream, AO, DM, w_out_b, DM, DM, DM, (void*)out, DM, (const float*)out);
    hipLaunchKernelGGL(nk_rmsnorm, dim3(SEQ), dim3(256), 0, stream, out, norm_c, H);
    hipLaunchKernelGGL(nk_gemm<0>, dim3(8192 / 64, SEQ / 64), dim3(256), 0, stream, H, DM, w_in_c, 8192, DM, 8192, (void*)PB, 8192, (const float*)nullptr);
    hipLaunchKernelGGL(nk_attn_sb, dim3(SEQ / 4, NH), dim3(256), 0, stream, PB, AO);
    hipLaunchKernelGGL(nk_gemm<1>, dim3(DM / 64, SEQ / 64), dim3(256), 0, stream, AO, DM, w_out_c, DM, DM, DM, (void*)out, DM, (const float*)out);
    hipLaunchKernelGGL(nk_rmsnorm, dim3(SEQ), dim3(256), 0, stream, out, norm_d, H);
    hipLaunchKernelGGL(nk_gemm<0>, dim3((7216 + 63) / 64, SEQ / 64), dim3(256), 0, stream, H, DM, w_in_d, 7216, DM, 7216, (void*)PB, LD3, (const float*)nullptr);
    hipLaunchKernelGGL(nk_headnorm, dim3(SEQ * 16 / 4), dim3(256), 0, stream, PB, LD3, 0, 16, q_norm_d);
    hipLaunchKernelGGL(nk_headnorm, dim3(SEQ * 4 / 4), dim3(256), 0, stream, PB, LD3, 3072, 4, k_norm_d + 128);
    hipLaunchKernelGGL(nk_headnorm, dim3(SEQ * 4 / 4), dim3(256), 0, stream, PB, LD3, 4096, 4, k_norm_d + 256);
    hipLaunchKernelGGL(nk_nsa_compress, dim3(511, 4), dim3(128), 0, stream, PB, 2048, w_cmp_k, cmp_pos, k_norm_d, KCMP);
    hipLaunchKernelGGL(nk_nsa_compress, dim3(511, 4), dim3(128), 0, stream, PB, 2560, w_cmp_v, cmp_pos, (const float*)nullptr, VCMP);
    hipLaunchKernelGGL(nk_attn_nsa, dim3(SEQ, 4), dim3(256), 0, stream, PB, KCMP, VCMP, AO);
    hipLaunchKernelGGL(nk_gemm<1>, dim3(DM / 64, SEQ / 64), dim3(256), 0, stream, AO, DM, w_out_d, DM, DM, DM, (void*)out, DM, (const float*)out);
}
```

```cpp
#include <hip/hip_runtime.h>
#include <stdint.h>
#include <math.h>

typedef unsigned short bf16_t;
typedef float f32x4 __attribute__((ext_vector_type(4)));
typedef unsigned u32x4 __attribute__((ext_vector_type(4)));

#define SEQ 8192
#define DM 2048
#define NH 16
#define HD 128

__device__ __forceinline__ bf16_t f2bf(float f) { unsigned u = __float_as_uint(f); u += 0x7fffu + ((u >> 16) & 1u); return (bf16_t)(u >> 16); }
__device__ __forceinline__ float bf2f(bf16_t h) { return __uint_as_float(((unsigned)h) << 16); }
__device__ __forceinline__ float wave_sum(float v) { for (int o = 32; o > 0; o >>= 1) v += __shfl_xor(v, o); return v; }
__device__ __forceinline__ float wave_max(float v) { for (int o = 32; o > 0; o >>= 1) v = fmaxf(v, __shfl_xor(v, o)); return v; }
__device__ __forceinline__ float silu_f(float x) { return x / (1.f + __expf(-x)); }
__device__ __forceinline__ float sigmoid_f(float x) { return 1.f / (1.f + __expf(-x)); }
__device__ __forceinline__ float alibi_slope(int h) { return exp2f(-0.5f * (float)(h + 1)); }
__device__ __forceinline__ float logsig(float x) { return fminf(x, 0.f) - log1pf(__expf(-fabsf(x))); }

constexpr size_t WS_BAR = 0;
constexpr size_t WS_ROPE = 16384;
constexpr size_t WS_H = WS_ROPE + (size_t)SEQ * 64 * 4;
constexpr size_t WS_AO = WS_H + (size_t)SEQ * DM * 2;
constexpr size_t WS_SMALL = WS_AO + (size_t)SEQ * DM * 2;
constexpr size_t WS_QL = WS_SMALL;
constexpr size_t WS_KVL = WS_QL + (size_t)SEQ * 512 * 2;
constexpr size_t WS_KR = WS_KVL + (size_t)SEQ * 256 * 2;
constexpr size_t WS_KMEAN = WS_KR + (size_t)SEQ * 64 * 2;
constexpr size_t WS_KCMP = WS_KMEAN + (size_t)16 * 32 * 128 * 4;
constexpr size_t WS_VCMP = WS_KCMP + (size_t)4 * 512 * 128 * 4;
constexpr size_t WS_ARENA = WS_VCMP + (size_t)4 * 512 * 128 * 4;
constexpr size_t AR_PB = 0;
constexpr size_t AR_QU = (size_t)SEQ * 3072 * 2;
constexpr size_t AR_KVU = AR_QU + (size_t)SEQ * 3072 * 2;
constexpr size_t WS_END = WS_ARENA + AR_KVU + (size_t)SEQ * 4096 * 2;


#define XB_TMO      128
#define XB_XCNT(j)  (256  + 64 * (j))
#define XB_XSUB(j)  (1280 + 64 * (j))
#define XB_XGEN(j)  (2304 + 64 * (j))
#define XB_TOP      3328
#define XB_TOPGEN   3392
#define XCD_BAR_WORDS 3456
#define XB_SPIN_CAP (1u << 22)
#define LAS __attribute__((address_space(3)))

__device__ __forceinline__ unsigned xb_ld(unsigned* p)              { return __hip_atomic_load(p, __ATOMIC_RELAXED, __HIP_MEMORY_SCOPE_AGENT); }
__device__ __forceinline__ unsigned xb_add(unsigned* p, unsigned v) { return __hip_atomic_fetch_add(p, v, __ATOMIC_RELAXED, __HIP_MEMORY_SCOPE_AGENT); }
__device__ __forceinline__ unsigned xb_xcc_id() { return (unsigned)__builtin_amdgcn_s_getreg((3 << 11) | 20) & 0xFu; }
#define XB_SPIN(cond, bar) do { unsigned _sp = 0; while (cond) { __builtin_amdgcn_s_sleep(1); \
    if ((++_sp & 255u) == 0u) { if (xb_ld(&(bar)[XB_TMO])) break; if (_sp > XB_SPIN_CAP) { atomicAdd(&(bar)[XB_TMO], 1u); break; } } } } while (0)

struct XcdBarrier {
    unsigned* bar; unsigned x;
    volatile LAS unsigned* st;
};
__device__ __forceinline__ XcdBarrier xcd_barrier_post(unsigned* bar, volatile LAS unsigned* st) {
    XcdBarrier b; b.bar = bar; b.x = xb_xcc_id(); b.st = st;
    if (threadIdx.x == 0) (void)xb_add(&bar[XB_XCNT(b.x)], 1u);
    return b;
}
__device__ __forceinline__ void xcd_barrier_complete(unsigned* bar, unsigned x, unsigned& nloc, unsigned& nx) {
    const unsigned G = gridDim.x * gridDim.y * gridDim.z;
    unsigned sum, cnt, mine, sp = 0u;
    for (;;) {
        sum = 0u; cnt = 0u; mine = 0u;
#pragma unroll
        for (unsigned j = 0; j < 16; ++j) { const unsigned c = xb_ld(&bar[XB_XCNT(j)]); sum += c; cnt += (c > 0u) ? 1u : 0u; mine = (j == x) ? c : mine; }
        if (sum == G) break;
        __builtin_amdgcn_s_sleep(1);
        if ((++sp & 255u) == 0u) { if (xb_ld(&bar[XB_TMO])) break; if (sp > XB_SPIN_CAP) { atomicAdd(&bar[XB_TMO], 1u); break; } }
    }
    nloc = mine > 0u ? mine : 1u; nx = cnt > 0u ? cnt : 1u;
}
__device__ __forceinline__ void xcd_barrier(const XcdBarrier& b) {
    asm volatile("s_waitcnt vmcnt(0)" ::: "memory");
    __syncthreads();
    if (threadIdx.x == 0) {
        unsigned* bar = b.bar;
        __builtin_amdgcn_s_waitcnt(0);
        unsigned nloc = b.st[0], nx = b.st[1];
        if (nloc == 0u) { xcd_barrier_complete(bar, b.x, nloc, nx); b.st[0] = nloc; b.st[1] = nx; }
        const unsigned old = xb_add(&bar[XB_XSUB(b.x)], 1u);
        const unsigned gen = old / nloc;
        if (old + 1u == (gen + 1u) * nloc) {
            __builtin_amdgcn_fence(__ATOMIC_RELEASE, "agent");
            asm volatile("s_waitcnt vmcnt(0)" ::: "memory");
            const unsigned og = xb_add(&bar[XB_TOP], 1u);
            const unsigned tg = og / nx;
            if (og + 1u == (tg + 1u) * nx) xb_add(&bar[XB_TOPGEN], 1u);
            else XB_SPIN(xb_ld(&bar[XB_TOPGEN]) == tg, bar);
            __builtin_amdgcn_fence(__ATOMIC_ACQUIRE, "agent");
            xb_add(&bar[XB_XGEN(b.x)], 1u);
            asm volatile("s_waitcnt vmcnt(0)" ::: "memory");
        } else {
            XB_SPIN(xb_ld(&bar[XB_XGEN(b.x)]) == gen, bar);
            __builtin_amdgcn_fence(__ATOMIC_ACQUIRE, "agent");
            asm volatile("s_waitcnt vmcnt(0)" ::: "memory");
        }
    }
    __syncthreads();
}
__device__ __forceinline__ void nk_rope_table(int bx, int by, int tid, unsigned char* sm, bool active, float* tab) {
    int idx = bx * 256 + tid;
    if (idx >= SEQ * 32) return;
    int pos = idx >> 5, i = idx & 31;
    float inv = powf(10000.f, -(float)(2 * i) / 64.f);
    float ang = (float)pos * inv;
    double a = (double)ang;
    tab[idx * 2 + 0] = (float)cos(a);
    tab[idx * 2 + 1] = (float)sin(a);
}

__device__ __forceinline__ void nk_rmsnorm(int bx, int by, int tid, unsigned char* sm, bool active, const float* __restrict__ x, const float* __restrict__ g, bf16_t* __restrict__ out) {
    float* red = (float*)sm;
    const int row = bx, t = tid;
    const float* xr = x + (size_t)row * DM;
    float v[8]; float ss = 0.f;
    for (int i = 0; i < 8; ++i) { v[i] = xr[t + i * 256]; ss += v[i] * v[i]; }
    ss = wave_sum(ss);
    if ((t & 63) == 0) red[t >> 6] = ss;
    __syncthreads();
    float tot = red[0] + red[1] + red[2] + red[3];
    float rinv = rsqrtf(tot / (float)DM + 1e-6f);
    for (int i = 0; i < 8; ++i) out[(size_t)row * DM + t + i * 256] = f2bf(v[i] * rinv * g[t + i * 256]);
}

template <int MODE>
__device__ __forceinline__ void nk_gemm(int bx, int by, int tid, unsigned char* sm, bool active, const bf16_t* __restrict__ A, int lda, const float* __restrict__ W, int ldw, int K, int N,
                                               void* C, int ldc, const float* res) {
    float (*As)[64] = (float (*)[64])sm;
    float (*Ws)[64] = (float (*)[64])(sm + 4096);
    const int bm = by * 64, bn = bx * 64;
    const int t = tid, tx = t & 15, ty = t >> 4;
    float acc[4][4];
    for (int i = 0; i < 4; ++i) for (int j = 0; j < 4; ++j) acc[i][j] = 0.f;
    const int ar = t >> 2, ak = (t & 3) * 4;
    const int wk = t >> 4, wc = (t & 15) * 4;
    for (int k0 = 0; k0 < K; k0 += 16) {
        const bf16_t* ap = A + (size_t)(bm + ar) * lda + k0 + ak;
        for (int i = 0; i < 4; ++i) As[ak + i][ar] = bf2f(ap[i]);
        const float* wp = W + (size_t)(k0 + wk) * ldw + bn + wc;
        for (int i = 0; i < 4; ++i) Ws[wk][wc + i] = (bn + wc + i < N) ? wp[i] : 0.f;
        __syncthreads();
#pragma unroll
        for (int kk = 0; kk < 16; ++kk) {
            float a[4], b[4];
            for (int i = 0; i < 4; ++i) a[i] = As[kk][ty * 4 + i];
            for (int j = 0; j < 4; ++j) b[j] = Ws[kk][tx * 4 + j];
            for (int i = 0; i < 4; ++i) for (int j = 0; j < 4; ++j) acc[i][j] += a[i] * b[j];
        }
        __syncthreads();
    }
    for (int i = 0; i < 4; ++i) for (int j = 0; j < 4; ++j) {
        const int r = bm + ty * 4 + i, c = bn + tx * 4 + j;
        if (c < N && active) {
            if (MODE == 0) ((bf16_t*)C)[(size_t)r * ldc + c] = f2bf(acc[i][j]);
            else ((float*)C)[(size_t)r * ldc + c] = res[(size_t)r * ldc + c] + acc[i][j];
        }
    }
}

__device__ __forceinline__ void nk_mla_prep1(int bx, int by, int tid, unsigned char* sm, bool active, const bf16_t* __restrict__ PB, const float* __restrict__ qln, const float* __restrict__ kvln,
                                                    const float* __restrict__ knorm, const float* __restrict__ rope,
                                                    bf16_t* __restrict__ QL, bf16_t* __restrict__ KVL, bf16_t* __restrict__ KR) {
    const int tok = bx, w = tid >> 6, lane = tid & 63;
    const bf16_t* p = PB + (size_t)tok * 3072;
    if (w == 0) {
        float v[8], ss = 0.f;
        for (int i = 0; i < 8; ++i) { v[i] = bf2f(p[lane + i * 64]); ss += v[i] * v[i]; }
        ss = wave_sum(ss); float r = rsqrtf(ss / 512.f + 1e-6f);
        for (int i = 0; i < 8; ++i) QL[(size_t)tok * 512 + lane + i * 64] = f2bf(v[i] * r * qln[lane + i * 64]);
    } else if (w == 1) {
        float v[4], ss = 0.f;
        for (int i = 0; i < 4; ++i) { v[i] = bf2f(p[512 + lane + i * 64]); ss += v[i] * v[i]; }
        ss = wave_sum(ss); float r = rsqrtf(ss / 256.f + 1e-6f);
        for (int i = 0; i < 4; ++i) KVL[(size_t)tok * 256 + lane + i * 64] = f2bf(v[i] * r * kvln[lane + i * 64]);
    } else if (w == 2) {
        float v = bf2f(p[768 + lane]); float ss = wave_sum(v * v); float r = rsqrtf(ss / 64.f + 1e-6f);
        v = v * r * knorm[128 + lane];
        float other = __shfl_xor(v, 32);
        const int i = lane & 31; const float c = rope[((size_t)tok * 32 + i) * 2], s = rope[((size_t)tok * 32 + i) * 2 + 1];
        float o = (lane < 32) ? (v * c - other * s) : (other * s + v * c);
        KR[(size_t)tok * 64 + lane] = f2bf(o);
    }
}
__device__ __forceinline__ void nk_mla_prep2(int bx, int by, int tid, unsigned char* sm, bool active, bf16_t* __restrict__ QU, bf16_t* __restrict__ KVU, const float* __restrict__ qnorm,
                                                    const float* __restrict__ knorm, const float* __restrict__ rope) {
    const int gw = bx * 4 + (tid >> 6), lane = tid & 63;
    const int tok = gw >> 4, h = gw & 15;
    bf16_t* q = QU + (size_t)tok * 3072 + h * 192;
    float a0 = bf2f(q[lane]), a1 = bf2f(q[lane + 64]);
    float ss = wave_sum(a0 * a0 + a1 * a1); float r = rsqrtf(ss / 128.f + 1e-6f);
    q[lane] = f2bf(a0 * r * qnorm[lane]); q[lane + 64] = f2bf(a1 * r * qnorm[lane + 64]);
    float v = bf2f(q[128 + lane]); float s2 = wave_sum(v * v); float r2 = rsqrtf(s2 / 64.f + 1e-6f);
    v = v * r2 * qnorm[128 + lane];
    float other = __shfl_xor(v, 32);
    const int i = lane & 31; const float c = rope[((size_t)tok * 32 + i) * 2], s = rope[((size_t)tok * 32 + i) * 2 + 1];
    float o = (lane < 32) ? (v * c - other * s) : (other * s + v * c);
    q[128 + lane] = f2bf(o);
    bf16_t* k = KVU + (size_t)tok * 4096 + h * 256;
    float b0 = bf2f(k[lane]), b1 = bf2f(k[lane + 64]);
    float s3 = wave_sum(b0 * b0 + b1 * b1); float r3 = rsqrtf(s3 / 128.f + 1e-6f);
    k[lane] = f2bf(b0 * r3 * knorm[lane]); k[lane + 64] = f2bf(b1 * r3 * knorm[lane + 64]);
}

__device__ __forceinline__ float dot_row(const float* q, const bf16_t* k, int n) {
    float s = 0.f;
    for (int i = 0; i < n; i += 8) {
        u32x4 w = *(const u32x4*)(k + i);
        s += q[i + 0] * __uint_as_float(w.x << 16) + q[i + 1] * __uint_as_float(w.x & 0xffff0000u);
        s += q[i + 2] * __uint_as_float(w.y << 16) + q[i + 3] * __uint_as_float(w.y & 0xffff0000u);
        s += q[i + 4] * __uint_as_float(w.z << 16) + q[i + 5] * __uint_as_float(w.z & 0xffff0000u);
        s += q[i + 6] * __uint_as_float(w.w << 16) + q[i + 7] * __uint_as_float(w.w & 0xffff0000u);
    }
    return s;
}
struct SoftAcc { float m, l, o0, o1; };
__device__ __forceinline__ void soft_tile(SoftAcc& a, float s, int key, const bf16_t* vbase, size_t vstride, int lane) {
    float tm = wave_max(s);
    if (tm == -INFINITY) return;
    float mn = fmaxf(a.m, tm);
    float alpha = __expf(a.m - mn);
    float p = (s == -INFINITY) ? 0.f : __expf(s - mn);
    a.l = a.l * alpha + wave_sum(p);
    a.o0 *= alpha; a.o1 *= alpha; a.m = mn;
    for (int j = 0; j < 64; ++j) {
        float pj = __shfl(p, j); int kj = __shfl(key, j);
        if (pj != 0.f) {
            unsigned w = *(const unsigned*)(vbase + (size_t)kj * vstride + 2 * lane);
            a.o0 += pj * __uint_as_float(w << 16); a.o1 += pj * __uint_as_float(w & 0xffff0000u);
        }
    }
}

__device__ __forceinline__ void nk_attn_mla(int bx, int by, int tid, unsigned char* sm, bool active, const bf16_t* __restrict__ QU, const bf16_t* __restrict__ KVU, const bf16_t* __restrict__ KR,
                                                   const bf16_t* __restrict__ PB, bf16_t* __restrict__ AO) {
    float (*qs)[192] = (float (*)[192])sm;
    const int w = tid >> 6, lane = tid & 63;
    const int h = by, tok = bx * 4 + w;
    const bf16_t* q = QU + (size_t)tok * 3072 + h * 192;
    for (int i = lane; i < 192; i += 64) qs[w][i] = bf2f(q[i]);
    __syncthreads();
    const float scale = 0.07216878364870322f;
    SoftAcc a{-INFINITY, 0.f, 0.f, 0.f};
    for (int k0 = 0; k0 <= tok; k0 += 64) {
        int key = k0 + lane; float s = -INFINITY;
        if (key <= tok) {
            s = dot_row(qs[w], KVU + (size_t)key * 4096 + h * 256, 128) + dot_row(qs[w] + 128, KR + (size_t)key * 64, 64);
            s *= scale;
        }
        soft_tile(a, s, key, KVU + h * 256 + 128, 4096, lane);
    }
    const float il = 1.f / a.l;
    const bf16_t* g = PB + (size_t)tok * 3072 + 832 + h * 128;
    unsigned gw = *(const unsigned*)(g + 2 * lane);
    float g0 = __uint_as_float(gw << 16), g1 = __uint_as_float(gw & 0xffff0000u);
    AO[(size_t)tok * DM + h * 128 + 2 * lane] = f2bf(a.o0 * il * silu_f(g0));
    AO[(size_t)tok * DM + h * 128 + 2 * lane + 1] = f2bf(a.o1 * il * silu_f(g1));
}

__device__ __forceinline__ void nk_headnorm(int bx, int by, int tid, unsigned char* sm, bool active, bf16_t* __restrict__ PB, int ld, int col0, int nheads, const float* __restrict__ g) {
    const int gw = bx * 4 + (tid >> 6), lane = tid & 63;
    const int tok = gw / nheads, h = gw % nheads;
    bf16_t* p = PB + (size_t)tok * ld + col0 + h * 128;
    float a0 = bf2f(p[lane]), a1 = bf2f(p[lane + 64]);
    float ss = wave_sum(a0 * a0 + a1 * a1); float r = rsqrtf(ss / 128.f + 1e-6f);
    p[lane] = f2bf(a0 * r * g[lane]); p[lane + 64] = f2bf(a1 * r * g[lane + 64]);
}
__device__ __forceinline__ void nk_kmean(int bx, int by, int tid, unsigned char* sm, bool active, const bf16_t* __restrict__ PB, float* __restrict__ kmean) {
    const int n = bx, h = by, d = tid;
    float s = 0.f;
    for (int i = 0; i < 256; ++i) s += bf2f(PB[(size_t)(n * 256 + i) * 8192 + 2048 + h * 128 + d]);
    if (active) kmean[((size_t)h * 32 + n) * 128 + d] = s * (1.f / 256.f);
}
__device__ __forceinline__ void nk_attn_moba(int bx, int by, int tid, unsigned char* sm, bool active, const bf16_t* __restrict__ PB, const float* __restrict__ kmean, bf16_t* __restrict__ AO) {
    float (*qs)[128] = (float (*)[128])sm;
    const int w = tid >> 6, lane = tid & 63;
    const int h = by, tok = bx * 4 + w;
    const bf16_t* q = PB + (size_t)tok * 8192 + h * 128;
    for (int i = lane; i < 128; i += 64) qs[w][i] = bf2f(q[i]);
    __syncthreads();
    const int own = tok >> 8;
    float sc = -INFINITY;
    if (lane < own) { const float* km = kmean + ((size_t)h * 32 + lane) * 128; float s = 0.f; for (int d = 0; d < 128; ++d) s += qs[w][d] * km[d]; sc = s; }
    int sel[3]; bool ok[3];
    for (int r = 0; r < 3; ++r) {
        float mx = wave_max(sc);
        unsigned long long bal = __ballot(sc == mx);
        int idx = __ffsll((long long)bal) - 1;
        sel[r] = idx; ok[r] = (mx > -INFINITY);
        if (lane == idx) sc = -INFINITY;
        if (!ok[r]) sel[r] = 0;
    }
    const float scale = 0.08838834764831845f, slope = alibi_slope(h);
    const bf16_t* kb = PB + 2048 + h * 128; const bf16_t* vb = PB + 4096 + h * 128;
    SoftAcc a{-INFINITY, 0.f, 0.f, 0.f};
    for (int r = 0; r < 3; ++r) if (ok[r]) {
        for (int k0 = sel[r] * 256; k0 < sel[r] * 256 + 256; k0 += 64) {
            int key = k0 + lane;
            float s = dot_row(qs[w], kb + (size_t)key * 8192, 128) * scale - slope * (float)(tok - key);
            soft_tile(a, s, key, vb, 8192, lane);
        }
    }
    for (int k0 = own * 256; k0 <= tok; k0 += 64) {
        int key = k0 + lane; float s = -INFINITY;
        if (key <= tok) s = dot_row(qs[w], kb + (size_t)key * 8192, 128) * scale - slope * (float)(tok - key);
        soft_tile(a, s, key, vb, 8192, lane);
    }
    const float il = 1.f / a.l;
    unsigned gw = *(const unsigned*)(PB + (size_t)tok * 8192 + 6144 + h * 128 + 2 * lane);
    float g0 = __uint_as_float(gw << 16), g1 = __uint_as_float(gw & 0xffff0000u);
    AO[(size_t)tok * DM + h * 128 + 2 * lane] = f2bf(a.o0 * il * silu_f(g0));
    AO[(size_t)tok * DM + h * 128 + 2 * lane + 1] = f2bf(a.o1 * il * silu_f(g1));
}

__device__ __forceinline__ void nk_attn_sb(int bx, int by, int tid, unsigned char* sm, bool active, const bf16_t* __restrict__ PB, bf16_t* __restrict__ AO) {
    float (*qs)[128] = (float (*)[128])sm;
    const int w = tid >> 6, lane = tid & 63;
    const int h = by, tok = bx * 4 + w;
    const bf16_t* q = PB + (size_t)tok * 8192 + h * 128;
    for (int i = lane; i < 128; i += 64) qs[w][i] = bf2f(q[i]);
    __syncthreads();
    const float scale = 0.08838834764831845f;
    const bf16_t* kb = PB + 2048 + h * 128; const bf16_t* vb = PB + 4096 + h * 128;
    float carry = 0.f, o0 = 0.f, o1 = 0.f;
    for (int j0 = 0; j0 < tok; j0 += 64) {
        int j = j0 + lane; int key = tok - 1 - j; bool valid = key >= 0;
        float z = 0.f;
        if (valid) z = dot_row(qs[w], kb + (size_t)key * 8192, 128) * scale;
        float lk = valid ? logsig(-z) : 0.f;
        float incl = lk;
        for (int o = 1; o < 64; o <<= 1) { float t = __shfl_up(incl, o); if (lane >= o) incl += t; }
        float excl = incl - lk;
        float a = valid ? __expf(logsig(z) + carry + excl) : 0.f;
        carry += __shfl(incl, 63);
        for (int jj = 0; jj < 64; ++jj) {
            float pj = __shfl(a, jj); int kj = __shfl(key, jj);
            if (pj != 0.f) {
                unsigned wv = *(const unsigned*)(vb + (size_t)kj * 8192 + 2 * lane);
                o0 += pj * __uint_as_float(wv << 16); o1 += pj * __uint_as_float(wv & 0xffff0000u);
            }
        }
        if (carry < -110.f) break;
    }
    unsigned gw = *(const unsigned*)(PB + (size_t)tok * 8192 + 6144 + h * 128 + 2 * lane);
    float g0 = __uint_as_float(gw << 16), g1 = __uint_as_float(gw & 0xffff0000u);
    AO[(size_t)tok * DM + h * 128 + 2 * lane] = f2bf(o0 * silu_f(g0));
    AO[(size_t)tok * DM + h * 128 + 2 * lane + 1] = f2bf(o1 * silu_f(g1));
}

#define LD3 7424
__device__ __forceinline__ void nk_nsa_compress(int bx, int by, int tid, unsigned char* sm, bool active, const bf16_t* __restrict__ PB, int col0, const float* __restrict__ Wc, const float* __restrict__ pos,
                                                       const float* __restrict__ gain, float* __restrict__ out) {
    float* blk = (float*)sm;
    float* red = (float*)(sm + 16384);
    const int n = bx, g = by, c = tid;
    for (int i = c; i < 4096; i += 128) { int l = i >> 7, d = i & 127; blk[i] = bf2f(PB[(size_t)(16 * n + l) * LD3 + col0 + g * 128 + d]) + pos[i]; }
    __syncthreads();
    float acc = 0.f;
    for (int k = 0; k < 4096; ++k) acc += blk[k] * Wc[(size_t)k * 128 + c];
    if (gain) {
        float ss = wave_sum(acc * acc);
        if ((c & 63) == 0) red[c >> 6] = ss;
        __syncthreads();
        float r = rsqrtf((red[0] + red[1]) / 128.f + 1e-6f);
        acc = acc * r * gain[c];
    }
    if (active) out[((size_t)g * 512 + n) * 128 + c] = acc;
}
__device__ __forceinline__ float dot_row_f32(const float* q, const float* k, int n) { float s = 0.f; for (int i = 0; i < n; ++i) s += q[i] * k[i]; return s; }
__device__ __forceinline__ void nk_attn_nsa(int bx, int by, int tid, unsigned char* sm, bool active, const bf16_t* __restrict__ PB, const float* __restrict__ kcmp, const float* __restrict__ vcmp,
                                                   bf16_t* __restrict__ AO) {
    float (*qs)[128] = (float (*)[128])sm;
    float (*sc)[512] = (float (*)[512])(sm + 2048);
    float* Psum = (float*)(sm + 2048 + 8192);
    float* imp = (float*)(sm + 2048 + 8192 + 2048);
    int* selidx = (int*)(sm + 2048 + 8192 + 2048 + 512);
    int* selok = (int*)(sm + 2048 + 8192 + 2048 + 512 + 64);
    const int w = tid >> 6, lane = tid & 63;
    const int tok = bx, g = by, h = g * 4 + w;
    const bf16_t* row = PB + (size_t)tok * LD3;
    for (int i = lane; i < 128; i += 64) qs[w][i] = bf2f(row[h * 128 + i]);
    for (int i = tid; i < 512; i += 256) Psum[i] = 0.f;
    __syncthreads();
    const float scale = 0.08838834764831845f, slope = alibi_slope(h);
    const int ncv = (tok >= 31) ? ((tok - 31) / 16 + 1) : 0;
    float oc0 = 0.f, oc1 = 0.f;
    if (ncv > 0) {
        float mx = -INFINITY;
        for (int n = lane; n < ncv; n += 64) {
            float s = dot_row_f32(qs[w], kcmp + ((size_t)g * 512 + n) * 128, 128) * scale - slope * (float)(tok - (16 * n + 31));
            sc[w][n] = s; mx = fmaxf(mx, s);
        }
        mx = wave_max(mx);
        float l = 0.f;
        for (int n = lane; n < ncv; n += 64) { float p = __expf(sc[w][n] - mx); sc[w][n] = p; l += p; }
        l = wave_sum(l);
        const float il = 1.f / l;
        for (int n = lane; n < ncv; n += 64) { float p = sc[w][n] * il; sc[w][n] = p; atomicAdd(&Psum[n], p); }
        __builtin_amdgcn_s_waitcnt(0);
        for (int n = 0; n < ncv; ++n) {
            float p = sc[w][n];
            const float* v = vcmp + ((size_t)g * 512 + n) * 128 + 2 * lane;
            oc0 += p * v[0]; oc1 += p * v[1];
        }
    }
    __syncthreads();
    const int cur = tok >> 6;
    if (tid < 128) {
        int j = tid; float s = 0.f;
        for (int i = 4 * j - 1; i <= 4 * j + 3; ++i) if (i >= 0 && i < 511) s += Psum[i];
        bool forced = (j == 0) || (j == cur) || (j == cur - 1);
        imp[j] = (j > cur) ? -INFINITY : (forced ? INFINITY : s);
    }
    __syncthreads();
    if (w == 0) {
        float v0 = imp[lane], v1 = imp[lane + 64];
        for (int r = 0; r < 16; ++r) {
            float mx = wave_max(fmaxf(v0, v1));
            unsigned long long b0 = __ballot(v0 == mx), b1 = __ballot(v1 == mx);
            int idx = b0 ? (__ffsll((long long)b0) - 1) : (64 + __ffsll((long long)b1) - 1);
            if (lane == 0) { selidx[r] = idx; selok[r] = (mx > -INFINITY) ? 1 : 0; }
            if (idx < 64) { if (lane == idx) v0 = -INFINITY; } else { if (lane == idx - 64) v1 = -INFINITY; }
        }
    }
    __syncthreads();
    const bf16_t* ksb = PB + 3072 + g * 128; const bf16_t* vsb = PB + 3584 + g * 128;
    SoftAcc as{-INFINITY, 0.f, 0.f, 0.f};
    for (int r = 0; r < 16; ++r) if (selok[r]) {
        int key = selidx[r] * 64 + lane; float s = -INFINITY;
        if (key <= tok) s = dot_row(qs[w], ksb + (size_t)key * LD3, 128) * scale - slope * (float)(tok - key);
        soft_tile(as, s, key, vsb, LD3, lane);
    }
    const bf16_t* kwb = PB + 4096 + g * 128; const bf16_t* vwb = PB + 4608 + g * 128;
    SoftAcc aw{-INFINITY, 0.f, 0.f, 0.f};
    int kstart = tok - 511; if (kstart < 0) kstart = 0;
    for (int k0 = kstart; k0 <= tok; k0 += 64) {
        int key = k0 + lane; float s = -INFINITY;
        if (key <= tok) s = dot_row(qs[w], kwb + (size_t)key * LD3, 128) * scale - slope * (float)(tok - key);
        soft_tile(aw, s, key, vwb, LD3, lane);
    }
    const bf16_t* gb = row + 5120 + h * 3;
    const float g0 = sigmoid_f(bf2f(gb[0])), g1 = sigmoid_f(bf2f(gb[1])), g2 = sigmoid_f(bf2f(gb[2]));
    const float ils = 1.f / as.l, ilw = 1.f / aw.l;
    float o0 = g0 * oc0 + g1 * as.o0 * ils + g2 * aw.o0 * ilw;
    float o1 = g0 * oc1 + g1 * as.o1 * ils + g2 * aw.o1 * ilw;
    unsigned gw = *(const unsigned*)(row + 5168 + h * 128 + 2 * lane);
    float ga = __uint_as_float(gw << 16), gb2 = __uint_as_float(gw & 0xffff0000u);
    AO[(size_t)tok * DM + h * 128 + 2 * lane] = f2bf(o0 * silu_f(ga));
    AO[(size_t)tok * DM + h * 128 + 2 * lane + 1] = f2bf(o1 * silu_f(gb2));
}


constexpr int NTHREADS = 512;
constexpr int LDS_BYTES = 147456;
constexpr int LDS_BARW = LDS_BYTES - 16;
constexpr int NPHASES = 24;
struct Args { const float* in[26]; float* out; unsigned char* ws; int ph_lo, ph_hi; };

#define VGRID(T, NBX, NBY, CALL) do { constexpr int NV_ = NTHREADS / (T); const int vsub_ = (int)threadIdx.x / (T); const int tid = (int)threadIdx.x % (T); \
    const long nblk_ = (long)(NBX) * (NBY); const long per_ = (long)gridDim.x * NV_; \
    for (long base_ = 0; base_ < nblk_; base_ += per_) { long vb_ = base_ + (long)blockIdx.x * NV_ + vsub_; const bool active = vb_ < nblk_; if (!active) vb_ = nblk_ - 1; \
        const int bx = (int)(vb_ % (NBX)), by = (int)(vb_ / (NBX)); unsigned char* sm = lds + vsub_ * 32768; (void)bx; (void)by; (void)sm; (void)active; \
        CALL; __syncthreads(); } } while (0)

__global__ void __launch_bounds__(NTHREADS, 2) fwd(Args a) {
    extern __shared__ __attribute__((aligned(16))) unsigned char lds[];
    if (threadIdx.x == 0) *(uint4*)(lds + LDS_BARW) = make_uint4(0u, 0u, 0u, 0u);
    __syncthreads();
    unsigned char* ws = a.ws;
    XcdBarrier bar = xcd_barrier_post((unsigned*)(ws + WS_BAR), (volatile LAS unsigned*)(lds + LDS_BARW));
    const float* x = a.in[0];
    const float* norm_a = a.in[1];  const float* w_in_a = a.in[2];  const float* q_lat_norm = a.in[3];
    const float* w_q_up = a.in[4];  const float* kv_lat_norm = a.in[5]; const float* w_kv_up = a.in[6];
    const float* q_norm_a = a.in[7]; const float* k_norm_a = a.in[8]; const float* w_out_a = a.in[9];
    const float* norm_b = a.in[10]; const float* w_in_b = a.in[11]; const float* q_norm_b = a.in[12];
    const float* k_norm_b = a.in[13]; const float* w_out_b = a.in[14];
    const float* norm_c = a.in[15]; const float* w_in_c = a.in[16]; const float* w_out_c = a.in[17];
    const float* norm_d = a.in[18]; const float* w_in_d = a.in[19]; const float* q_norm_d = a.in[20];
    const float* k_norm_d = a.in[21]; const float* w_cmp_k = a.in[22]; const float* w_cmp_v = a.in[23];
    const float* cmp_pos = a.in[24]; const float* w_out_d = a.in[25];
    float* out = a.out;
    float* rope = (float*)(ws + WS_ROPE);
    bf16_t* H = (bf16_t*)(ws + WS_H); bf16_t* AO = (bf16_t*)(ws + WS_AO);
    bf16_t* QL = (bf16_t*)(ws + WS_QL); bf16_t* KVL = (bf16_t*)(ws + WS_KVL); bf16_t* KR = (bf16_t*)(ws + WS_KR);
    float* KMEAN = (float*)(ws + WS_KMEAN); float* KCMP = (float*)(ws + WS_KCMP); float* VCMP = (float*)(ws + WS_VCMP);
    bf16_t* PB = (bf16_t*)(ws + WS_ARENA + AR_PB); bf16_t* QU = (bf16_t*)(ws + WS_ARENA + AR_QU); bf16_t* KVU = (bf16_t*)(ws + WS_ARENA + AR_KVU);
    const int lo = a.ph_lo, hi = a.ph_hi;
#define IN(k) (lo <= (k) && (k) < hi)
#define SEAM(k) do { if (IN(k) && IN((k) + 1)) xcd_barrier(bar); } while (0)

    if (IN(0)) { VGRID(256, SEQ * 32 / 256, 1, nk_rope_table(bx, by, tid, sm, active, rope));
                 VGRID(256, SEQ, 1, nk_rmsnorm(bx, by, tid, sm, active, x, norm_a, H)); } SEAM(0);
    if (IN(1)) { VGRID(256, 2880 / 64, SEQ / 64, nk_gemm<0>(bx, by, tid, sm, active, H, DM, w_in_a, 2880, DM, 2880, (void*)PB, 3072, (const float*)nullptr)); } SEAM(1);
    if (IN(2)) { VGRID(256, SEQ, 1, nk_mla_prep1(bx, by, tid, sm, active, PB, q_lat_norm, kv_lat_norm, k_norm_a, rope, QL, KVL, KR)); } SEAM(2);
    if (IN(3)) { VGRID(256, 3072 / 64, SEQ / 64, nk_gemm<0>(bx, by, tid, sm, active, QL, 512, w_q_up, 3072, 512, 3072, (void*)QU, 3072, (const float*)nullptr));
                 VGRID(256, 4096 / 64, SEQ / 64, nk_gemm<0>(bx, by, tid, sm, active, KVL, 256, w_kv_up, 4096, 256, 4096, (void*)KVU, 4096, (const float*)nullptr)); } SEAM(3);
    if (IN(4)) { VGRID(256, SEQ * 16 / 4, 1, nk_mla_prep2(bx, by, tid, sm, active, QU, KVU, q_norm_a, k_norm_a, rope)); } SEAM(4);
    if (IN(5)) { VGRID(256, SEQ / 4, NH, nk_attn_mla(bx, by, tid, sm, active, QU, KVU, KR, PB, AO)); } SEAM(5);
    if (IN(6)) { VGRID(256, DM / 64, SEQ / 64, nk_gemm<1>(bx, by, tid, sm, active, AO, DM, w_out_a, DM, DM, DM, (void*)out, DM, x)); } SEAM(6);
    if (IN(7)) { VGRID(256, SEQ, 1, nk_rmsnorm(bx, by, tid, sm, active, out, norm_b, H)); } SEAM(7);
    if (IN(8)) { VGRID(256, 8192 / 64, SEQ / 64, nk_gemm<0>(bx, by, tid, sm, active, H, DM, w_in_b, 8192, DM, 8192, (void*)PB, 8192, (const float*)nullptr)); } SEAM(8);
    if (IN(9)) { VGRID(256, SEQ * 16 / 4, 1, nk_headnorm(bx, by, tid, sm, active, PB, 8192, 0, 16, q_norm_b));
                 VGRID(256, SEQ * 16 / 4, 1, nk_headnorm(bx, by, tid, sm, active, PB, 8192, 2048, 16, k_norm_b)); } SEAM(9);
    if (IN(10)) { VGRID(128, 32, NH, nk_kmean(bx, by, tid, sm, active, PB, KMEAN)); } SEAM(10);
    if (IN(11)) { VGRID(256, SEQ / 4, NH, nk_attn_moba(bx, by, tid, sm, active, PB, KMEAN, AO)); } SEAM(11);
    if (IN(12)) { VGRID(256, DM / 64, SEQ / 64, nk_gemm<1>(bx, by, tid, sm, active, AO, DM, w_out_b, DM, DM, DM, (void*)out, DM, (const float*)out)); } SEAM(12);
    if (IN(13)) { VGRID(256, SEQ, 1, nk_rmsnorm(bx, by, tid, sm, active, out, norm_c, H)); } SEAM(13);
    if (IN(14)) { VGRID(256, 8192 / 64, SEQ / 64, nk_gemm<0>(bx, by, tid, sm, active, H, DM, w_in_c, 8192, DM, 8192, (void*)PB, 8192, (const float*)nullptr)); } SEAM(14);
    if (IN(15)) { VGRID(256, SEQ / 4, NH, nk_attn_sb(bx, by, tid, sm, active, PB, AO)); } SEAM(15);
    if (IN(16)) { VGRID(256, DM / 64, SEQ / 64, nk_gemm<1>(bx, by, tid, sm, active, AO, DM, w_out_c, DM, DM, DM, (void*)out, DM, (const float*)out)); } SEAM(16);
    if (IN(17)) { VGRID(256, SEQ, 1, nk_rmsnorm(bx, by, tid, sm, active, out, norm_d, H)); } SEAM(17);
    if (IN(18)) { VGRID(256, (7216 + 63) / 64, SEQ / 64, nk_gemm<0>(bx, by, tid, sm, active, H, DM, w_in_d, 7216, DM, 7216, (void*)PB, LD3, (const float*)nullptr)); } SEAM(18);
    if (IN(19)) { VGRID(256, SEQ * 16 / 4, 1, nk_headnorm(bx, by, tid, sm, active, PB, LD3, 0, 16, q_norm_d));
                  VGRID(256, SEQ * 4 / 4, 1, nk_headnorm(bx, by, tid, sm, active, PB, LD3, 3072, 4, k_norm_d + 128));
                  VGRID(256, SEQ * 4 / 4, 1, nk_headnorm(bx, by, tid, sm, active, PB, LD3, 4096, 4, k_norm_d + 256));
                  VGRID(128, 511, 4, nk_nsa_compress(bx, by, tid, sm, active, PB, 2048, w_cmp_k, cmp_pos, k_norm_d, KCMP));
                  VGRID(128, 511, 4, nk_nsa_compress(bx, by, tid, sm, active, PB, 2560, w_cmp_v, cmp_pos, (const float*)nullptr, VCMP)); } SEAM(19);
    if (IN(20)) { VGRID(256, SEQ, 4, nk_attn_nsa(bx, by, tid, sm, active, PB, KCMP, VCMP, AO)); } SEAM(20);
    if (IN(21)) { VGRID(256, DM / 64, SEQ / 64, nk_gemm<1>(bx, by, tid, sm, active, AO, DM, w_out_d, DM, DM, DM, (void*)out, DM, (const float*)out)); }
#undef IN
#undef SEAM
}

#ifndef N_LAUNCH_PER_PHASE
#define N_LAUNCH_PER_PHASE 0
#endif
extern "C" void kernel_launch(void* const* d_in, const int* in_sizes, int n_in, void* d_out, int out_size, void* d_ws, size_t ws_size, hipStream_t stream) {
    static int ready = 0;
    if (ready == 0) {
        if (n_in != 26 || ws_size < WS_END) { ready = -1; return; }
        if (hipFuncSetAttribute((const void*)fwd, hipFuncAttributeMaxDynamicSharedMemorySize, LDS_BYTES) != hipSuccess) { ready = -1; return; }
        int per_cu = 0; (void)hipOccupancyMaxActiveBlocksPerMultiprocessor(&per_cu, (const void*)fwd, NTHREADS, LDS_BYTES); (void)hipGetLastError();
        ready = 1;
    }
    if (ready < 0) return;
    (void)hipMemsetAsync((char*)d_ws + WS_BAR, 0, 16384, stream);
    Args a{};
    for (int i = 0; i < 26; ++i) a.in[i] = (const float*)d_in[i];
    a.out = (float*)d_out; a.ws = (unsigned char*)d_ws;
#if N_LAUNCH_PER_PHASE
    for (int p = 0; p < 22; ++p) { a.ph_lo = p; a.ph_hi = p + 1; hipLaunchKernelGGL(fwd, dim3(256), dim3(NTHREADS), LDS_BYTES, stream, a); }
#else
    a.ph_lo = 0; a.ph_hi = 22;
    hipLaunchKernelGGL(fwd, dim3(256), dim3(NTHREADS), LDS_BYTES, stream, a);
#endif
}
```

```cpp
#include <hip/hip_runtime.h>
#include <stdint.h>
#include <math.h>

typedef unsigned short bf16_t;
typedef float f32x4 __attribute__((ext_vector_type(4)));
typedef unsigned u32x4 __attribute__((ext_vector_type(4)));

#define SEQ 8192
#define DM 2048
#define NH 16
#define HD 128

__device__ __forceinline__ bf16_t f2bf(float f) { unsigned u = __float_as_uint(f); u += 0x7fffu + ((u >> 16) & 1u); return (bf16_t)(u >> 16); }
__device__ __forceinline__ float bf2f(bf16_t h) { return __uint_as_float(((unsigned)h) << 16); }
__device__ __forceinline__ float wave_sum(float v) { for (int o = 32; o > 0; o >>= 1) v += __shfl_xor(v, o); return v; }
__device__ __forceinline__ float wave_max(float v) { for (int o = 32; o > 0; o >>= 1) v = fmaxf(v, __shfl_xor(v, o)); return v; }
__device__ __forceinline__ float silu_f(float x) { return x / (1.f + __expf(-x)); }
__device__ __forceinline__ float sigmoid_f(float x) { return 1.f / (1.f + __expf(-x)); }
__device__ __forceinline__ float alibi_slope(int h) { return exp2f(-0.5f * (float)(h + 1)); }
__device__ __forceinline__ float logsig(float x) { return fminf(x, 0.f) - log1pf(__expf(-fabsf(x))); }

constexpr size_t WS_BAR = 0;
constexpr size_t WS_RSS = 16384;
constexpr size_t WS_C0 = WS_RSS + (size_t)3 * SEQ * 8;
constexpr size_t WS_SPLIT = WS_C0 + 2048;
constexpr size_t WS_LSS = WS_SPLIT + 2048;
constexpr size_t WS_CTL_BYTES = WS_LSS + (size_t)2 * SEQ * 8;
constexpr size_t WS_ROPE = WS_CTL_BYTES;
constexpr size_t WS_H = WS_ROPE + (size_t)SEQ * 64 * 4;
constexpr size_t WS_AO = WS_H + (size_t)SEQ * DM * 2;
constexpr size_t WS_SMALL = WS_AO + (size_t)SEQ * DM * 2;
constexpr size_t WS_QL = WS_SMALL;
constexpr size_t WS_KVL = WS_QL + (size_t)SEQ * 512 * 2;
constexpr size_t WS_KR = WS_KVL + (size_t)SEQ * 256 * 2;
constexpr size_t WS_KMEAN = WS_KR + (size_t)SEQ * 64 * 2;
constexpr size_t WS_KCMP = WS_KMEAN + (size_t)256 * 2048 * 4;
constexpr size_t WS_VCMP = WS_KCMP + (size_t)4 * 512 * 128 * 4;
constexpr size_t WS_ARENA = WS_VCMP + (size_t)4 * 512 * 128 * 4;
constexpr size_t AR_PB = 0;
constexpr size_t AR_QU = (size_t)SEQ * 3072 * 2;
constexpr size_t AR_KVU = AR_QU + (size_t)SEQ * 3072 * 2;
constexpr size_t WS_W = WS_ARENA + AR_KVU + (size_t)SEQ * 4096 * 2;
constexpr size_t WB_IN = 0;
constexpr size_t WB_OUT = (size_t)8192 * 2048 * 2;
constexpr size_t WB_QUP = WB_OUT + (size_t)2048 * 2048 * 2;
constexpr size_t WB_KVUP = WB_QUP + (size_t)3072 * 512 * 2;
constexpr size_t WB_CK = WB_KVUP + (size_t)4096 * 256 * 2;
constexpr size_t WB_CV = WB_CK + (size_t)128 * 4096 * 2;
constexpr size_t WREG = WB_CV + (size_t)128 * 4096 * 2;
constexpr size_t WS_END = WS_W + 2 * WREG;
constexpr int CQ_WORD0 = 3584;

#define XB_TMO      128
#define XB_XCNT(j)  (256  + 64 * (j))
#define XB_XSUB(j)  (1280 + 64 * (j))
#define XB_XGEN(j)  (2304 + 64 * (j))
#define XB_TOP      3328
#define XB_TOPGEN   3392
#define XCD_BAR_WORDS 3456
#define XB_SPIN_CAP (1u << 22)
#define LAS __attribute__((address_space(3)))

__device__ __forceinline__ unsigned xb_ld(unsigned* p)              { return __hip_atomic_load(p, __ATOMIC_RELAXED, __HIP_MEMORY_SCOPE_AGENT); }
__device__ __forceinline__ unsigned xb_add(unsigned* p, unsigned v) { return __hip_atomic_fetch_add(p, v, __ATOMIC_RELAXED, __HIP_MEMORY_SCOPE_AGENT); }
__device__ __forceinline__ unsigned xb_xcc_id() { return (unsigned)__builtin_amdgcn_s_getreg((3 << 11) | 20) & 0xFu; }
#define XB_SPIN(cond, bar) do { unsigned _sp = 0; while (cond) { __builtin_amdgcn_s_sleep(1); \
    if ((++_sp & 255u) == 0u) { if (xb_ld(&(bar)[XB_TMO])) break; if (_sp > XB_SPIN_CAP) { atomicAdd(&(bar)[XB_TMO], 1u); break; } } } } while (0)

struct XcdBarrier {
    unsigned* bar; unsigned x;
    volatile LAS unsigned* st;
};
__device__ __forceinline__ XcdBarrier xcd_barrier_post(unsigned* bar, volatile LAS unsigned* st) {
    XcdBarrier b; b.bar = bar; b.x = xb_xcc_id(); b.st = st;
    if (threadIdx.x == 0) (void)xb_add(&bar[XB_XCNT(b.x)], 1u);
    return b;
}
__device__ __forceinline__ void xcd_barrier_complete(unsigned* bar, unsigned x, unsigned& nloc, unsigned& nx) {
    const unsigned G = gridDim.x * gridDim.y * gridDim.z;
    unsigned sum, cnt, mine, sp = 0u;
    for (;;) {
        sum = 0u; cnt = 0u; mine = 0u;
#pragma unroll
        for (unsigned j = 0; j < 16; ++j) { const unsigned c = xb_ld(&bar[XB_XCNT(j)]); sum += c; cnt += (c > 0u) ? 1u : 0u; mine = (j == x) ? c : mine; }
        if (sum == G) break;
        __builtin_amdgcn_s_sleep(1);
        if ((++sp & 255u) == 0u) { if (xb_ld(&bar[XB_TMO])) break; if (sp > XB_SPIN_CAP) { atomicAdd(&bar[XB_TMO], 1u); break; } }
    }
    nloc = mine > 0u ? mine : 1u; nx = cnt > 0u ? cnt : 1u;
}
__device__ __forceinline__ void xcd_barrier(const XcdBarrier& b) {
    asm volatile("s_waitcnt vmcnt(0)" ::: "memory");
    __syncthreads();
    if (threadIdx.x == 0) {
        unsigned* bar = b.bar;
        __builtin_amdgcn_s_waitcnt(0);
        unsigned nloc = b.st[0], nx = b.st[1];
        if (nloc == 0u) { xcd_barrier_complete(bar, b.x, nloc, nx); b.st[0] = nloc; b.st[1] = nx; }
        const unsigned old = xb_add(&bar[XB_XSUB(b.x)], 1u);
        const unsigned gen = old / nloc;
        if (old + 1u == (gen + 1u) * nloc) {
            __builtin_amdgcn_fence(__ATOMIC_RELEASE, "agent");
            asm volatile("s_waitcnt vmcnt(0)" ::: "memory");
            const unsigned og = xb_add(&bar[XB_TOP], 1u);
            const unsigned tg = og / nx;
            if (og + 1u == (tg + 1u) * nx) xb_add(&bar[XB_TOPGEN], 1u);
            else XB_SPIN(xb_ld(&bar[XB_TOPGEN]) == tg, bar);
            __builtin_amdgcn_fence(__ATOMIC_ACQUIRE, "agent");
            xb_add(&bar[XB_XGEN(b.x)], 1u);
            asm volatile("s_waitcnt vmcnt(0)" ::: "memory");
        } else {
            XB_SPIN(xb_ld(&bar[XB_XGEN(b.x)]) == gen, bar);
            __builtin_amdgcn_fence(__ATOMIC_ACQUIRE, "agent");
            asm volatile("s_waitcnt vmcnt(0)" ::: "memory");
        }
    }
    __syncthreads();
}
__device__ __forceinline__ void nk_rope_table(int bx, int by, int tid, unsigned char* sm, bool active, float* tab) {
    int idx = bx * 256 + tid;
    if (idx >= SEQ * 32) return;
    int pos = idx >> 5, i = idx & 31;
    float inv = powf(10000.f, -(float)(2 * i) / 64.f);
    float ang = (float)pos * inv;
    double a = (double)ang;
    tab[idx * 2 + 0] = (float)cos(a);
    tab[idx * 2 + 1] = (float)sin(a);
}

#define LD3 7424

namespace pg8 {
#define PG8_LAS __attribute__((address_space(3)))
typedef unsigned short bf16_t;
typedef short bf16x8 __attribute__((ext_vector_type(8)));
typedef float f32x4 __attribute__((ext_vector_type(4)));
typedef unsigned u32x4 __attribute__((ext_vector_type(4)));
constexpr int BM = 256, BK = 64, HALF = 128, HTB = HALF * BK * 2  , STAGE_BYTES = 8 * HTB, NXCD = 8, WGM = 8;

__host__ __device__ __forceinline__ int lds_byte(int r, int c) { const int st = (r >> 4) * 2 + (c >> 5), rr = r & 15, cc = c & 31, ob = rr * 64 + cc * 2; return st * 1024 + (ob ^ (((ob >> 9) & 1) << 5)); }
__host__ __device__ __forceinline__ void stage_rc(int b, int& R, int& C) { const int st = b / 1024, sb = b % 1024, swz = sb ^ (((sb >> 9) & 1) << 5); R = (st >> 1) * 16 + swz / 64; C = (st & 1) * 32 + (swz % 64) / 2; }
__host__ __device__ __forceinline__ int perm32(int rho) { const int n = rho >> 4, i = rho & 15; return 8 * (i >> 2) + 4 * n + (i & 3); }

struct Unit { int pm, pn; };
struct Gemm { const bf16_t* A; const bf16_t* Bt; int M, N, K; };

struct StaticOrder {
    int nM, nN, nwg, G, c;
    __host__ __device__ void init(int M, int N, int G_, int c_) { nM = M / BM; nN = N / BM; nwg = nM * nN; G = G_; c = c_; }
    __host__ __device__ bool next(int i, Unit& u) const {
        const long L = (long)i * G + c; if (L >= nwg) return false;
        int wgid = (int)L; { const int q = nwg / NXCD, r = nwg % NXCD, xcd = wgid % NXCD, off = wgid / NXCD; wgid = (xcd < r ? xcd * (q + 1) : r * (q + 1) + (xcd - r) * q) + off; }
        const int nig = WGM * nN, gid = wgid / nig, fm = gid * WGM, gsz = (nM - fm) < WGM ? (nM - fm) : WGM;
        u.pm = fm + ((wgid % nig) % gsz); u.pn = (wgid % nig) / gsz; return true;
    }
    __device__ __forceinline__ void a_ready(const Unit&) const {}
    __device__ __forceinline__ void done(const Unit&) const {}
};
__device__ __forceinline__ unsigned cvt_pk_bf16(float lo, float hi) { unsigned r; asm volatile("v_cvt_pk_bf16_f32 %0, %1, %2" : "=v"(r) : "v"(lo), "v"(hi)); return r; }
typedef float f32x2 __attribute__((ext_vector_type(2)));
typedef unsigned long long u64acc;
__device__ __forceinline__ void acc_add_fx(u64acc* p, float v) { atomicAdd(p, (unsigned long long)(v * 16777216.f + 0.5f)); }
__device__ __forceinline__ float acc_get_fx(const u64acc* p) { return (float)((double)(*p) * (1.0 / 16777216.0)); }
__device__ __forceinline__ f32x2 gelu_pk(f32x2 v) {
    const f32x2 av = __builtin_elementwise_abs(v), d = av * 0.2316418882f + 1.0f;
    f32x2 t; t.x = __builtin_amdgcn_rcpf(d.x); t.y = __builtin_amdgcn_rcpf(d.y);
    f32x2 q = t * 0.5307027145f + (-0.7265760135f); q = q * t + 0.7107068705f; q = q * t + (-0.142248368f); q = q * t + 0.127414796f; q = q * t;
    const f32x2 s = (v * v) * (-0.72134752044f);
    f32x2 e; e.x = __builtin_amdgcn_exp2f(s.x); e.y = __builtin_amdgcn_exp2f(s.y);
    const f32x2 m = v * (q * e), r = v - m;
    f32x2 o; o.x = v.x < 0.f ? m.x : r.x; o.y = v.y < 0.f ? m.y : r.y; return o;
}

struct EpiF32 {
    static constexpr bool PERM = false, AFTER_DRAIN = false;
    float* C; int ldc; const float* bias;
    __device__ __forceinline__ void operator()(const f32x4 (&acc)[2][2][4][2], const Unit& u, int wr, int wc, int fr, int fq) const {
        const int row0 = u.pm * BM + wr * 64 + fr, col0 = u.pn * BM + wc * 32 + 4 * fq;
        f32x4 bv[2][2];
#pragma unroll
        for (int bj = 0; bj < 2; ++bj)
#pragma unroll
            for (int n = 0; n < 2; ++n) bv[bj][n] = bias ? *(const f32x4*)(bias + col0 + bj * HALF + n * 16) : (f32x4){0.f, 0.f, 0.f, 0.f};
#pragma unroll
        for (int ai = 0; ai < 2; ++ai)
#pragma unroll
            for (int m = 0; m < 4; ++m) { float* rowp = C + (size_t)(row0 + ai * HALF + m * 16) * ldc + col0;
#pragma unroll
                for (int bj = 0; bj < 2; ++bj)
#pragma unroll
                    for (int n = 0; n < 2; ++n) *(f32x4*)(rowp + bj * HALF + n * 16) = acc[ai][bj][m][n] + bv[bj][n]; }
    }
};
template <int ACT  > struct EpiBf16 {
    static constexpr bool PERM = true, AFTER_DRAIN = false;
    bf16_t* O; int ldc; const float* bias; int split_cols; size_t split_stride;
    __device__ __forceinline__ void operator()(const f32x4 (&acc)[2][2][4][2], const Unit& u, int wr, int wc, int fr, int fq) const {
        const int row0 = u.pm * BM + wr * 64 + fr; int colt = u.pn * BM; bf16_t* base = O;
        if (split_cols) { const int t = colt / split_cols; base += (size_t)t * split_stride; colt -= t * split_cols; }
        const int col0 = colt + wc * 32 + 8 * fq, bcol0 = u.pn * BM + wc * 32 + 8 * fq;
        f32x4 bv[2][2];
#pragma unroll
        for (int bj = 0; bj < 2; ++bj)
#pragma unroll
            for (int n = 0; n < 2; ++n) bv[bj][n] = bias ? *(const f32x4*)(bias + bcol0 + bj * HALF + 4 * n) : (f32x4){0.f, 0.f, 0.f, 0.f};
#pragma unroll
        for (int ai = 0; ai < 2; ++ai)
#pragma unroll
            for (int m = 0; m < 4; ++m) { bf16_t* rowp = base + (size_t)(row0 + ai * HALF + m * 16) * ldc + col0;
#pragma unroll
                for (int bj = 0; bj < 2; ++bj) { f32x4 v0 = acc[ai][bj][m][0] + bv[bj][0], v1 = acc[ai][bj][m][1] + bv[bj][1];
                    if (ACT == 1) { f32x2 a = gelu_pk((f32x2){v0[0], v0[1]}), b = gelu_pk((f32x2){v0[2], v0[3]}), c = gelu_pk((f32x2){v1[0], v1[1]}), d = gelu_pk((f32x2){v1[2], v1[3]});
                        v0 = (f32x4){a.x, a.y, b.x, b.y}; v1 = (f32x4){c.x, c.y, d.x, d.y}; }
                    if (ACT == 2) {
#pragma unroll
                        for (int j = 0; j < 4; ++j) { v0[j] = 0.5f * v0[j] * (1.0f + erff(v0[j] * 0.70710678f)); v1[j] = 0.5f * v1[j] * (1.0f + erff(v1[j] * 0.70710678f)); } }
                    u32x4 w; w.x = cvt_pk_bf16(v0[0], v0[1]); w.y = cvt_pk_bf16(v0[2], v0[3]); w.z = cvt_pk_bf16(v1[0], v1[1]); w.w = cvt_pk_bf16(v1[2], v1[3]);
                    *(u32x4*)(rowp + bj * HALF) = w; } }
    }
};

struct EpiResF32 {
    static constexpr bool PERM = false, AFTER_DRAIN = false;
    const float* res; float* out; int ldc;
    __device__ __forceinline__ void operator()(const f32x4 (&acc)[2][2][4][2], const Unit& u, int wr, int wc, int fr, int fq) const {
        const int row0 = u.pm * BM + wr * 64 + fr, col0 = u.pn * BM + wc * 32 + 4 * fq;
        const float* __restrict__ rp = res; float* __restrict__ op = out;
#pragma unroll
        for (int ai = 0; ai < 2; ++ai) {
            f32x4 r[4][2][2];
#pragma unroll
            for (int m = 0; m < 4; ++m) { const size_t ro = (size_t)(row0 + ai * HALF + m * 16) * ldc + col0;
#pragma unroll
                for (int bj = 0; bj < 2; ++bj)
#pragma unroll
                    for (int n = 0; n < 2; ++n) r[m][bj][n] = *(const f32x4*)(rp + ro + bj * HALF + n * 16); }
#pragma unroll
            for (int m = 0; m < 4; ++m) { const size_t ro = (size_t)(row0 + ai * HALF + m * 16) * ldc + col0;
#pragma unroll
                for (int bj = 0; bj < 2; ++bj)
#pragma unroll
                    for (int n = 0; n < 2; ++n) *(f32x4*)(op + ro + bj * HALF + n * 16) = r[m][bj][n] + acc[ai][bj][m][n]; }
        }
    }
};

struct EpiResF32X {
    static constexpr bool PERM = false, AFTER_DRAIN = false;
    const float* res; float* out; bf16_t* xb; u64acc* rss; int ldc;
    __device__ __forceinline__ void operator()(const f32x4 (&acc)[2][2][4][2], const Unit& u, int wr, int wc, int fr, int fq) const {
        const int row0 = u.pm * BM + wr * 64 + fr, col0 = u.pn * BM + wc * 32 + 4 * fq;
        const float* __restrict__ rp = res; float* __restrict__ op = out;
#pragma unroll
        for (int ai = 0; ai < 2; ++ai) {
            f32x4 r[4][2][2];
#pragma unroll
            for (int m = 0; m < 4; ++m) { const size_t ro = (size_t)(row0 + ai * HALF + m * 16) * ldc + col0;
#pragma unroll
                for (int bj = 0; bj < 2; ++bj)
#pragma unroll
                    for (int n = 0; n < 2; ++n) r[m][bj][n] = *(const f32x4*)(rp + ro + bj * HALF + n * 16); }
#pragma unroll
            for (int m = 0; m < 4; ++m) { const int row = row0 + ai * HALF + m * 16; const size_t ro = (size_t)row * ldc + col0;
                float ss = 0.f;
#pragma unroll
                for (int bj = 0; bj < 2; ++bj)
#pragma unroll
                    for (int n = 0; n < 2; ++n) { const f32x4 v = r[m][bj][n] + acc[ai][bj][m][n]; *(f32x4*)(op + ro + bj * HALF + n * 16) = v;
                        uint2 w; w.x = cvt_pk_bf16(v[0], v[1]); w.y = cvt_pk_bf16(v[2], v[3]); *(uint2*)(xb + ro + bj * HALF + n * 16) = w;
                        ss += (v[0] * v[0] + v[1] * v[1]) + (v[2] * v[2] + v[3] * v[3]); }
                ss += __shfl_xor(ss, 16); ss += __shfl_xor(ss, 32);
                if (fq == 0) acc_add_fx(rss + row, ss); }
        }
    }
};

struct EpiMlaIn {
    static constexpr bool PERM = true, AFTER_DRAIN = false;
    bf16_t* PBo; int ldc; bf16_t* QLo; bf16_t* KVLo; u64acc* qss; u64acc* kvss;
    __device__ __forceinline__ void operator()(const f32x4 (&acc)[2][2][4][2], const Unit& u, int wr, int wc, int fr, int fq) const {
        const int row0 = u.pm * BM + wr * 64 + fr, cl = wc * 32 + 8 * fq;
        bf16_t* base; int ld; u64acc* ssp;
        if (u.pn < 2) { base = QLo + u.pn * 256; ld = 512; ssp = qss; } else if (u.pn == 2) { base = KVLo; ld = 256; ssp = kvss; } else { base = PBo + u.pn * 256; ld = ldc; ssp = nullptr; }
#pragma unroll
        for (int ai = 0; ai < 2; ++ai)
#pragma unroll
            for (int m = 0; m < 4; ++m) { const int row = row0 + ai * HALF + m * 16; bf16_t* rowp = base + (size_t)row * ld + cl;
                float ss = 0.f;
#pragma unroll
                for (int bj = 0; bj < 2; ++bj) { const f32x4 v0 = acc[ai][bj][m][0], v1 = acc[ai][bj][m][1];
                    u32x4 w; w.x = cvt_pk_bf16(v0[0], v0[1]); w.y = cvt_pk_bf16(v0[2], v0[3]); w.z = cvt_pk_bf16(v1[0], v1[1]); w.w = cvt_pk_bf16(v1[2], v1[3]);
                    *(u32x4*)(rowp + bj * HALF) = w;
                    ss += ((v0[0] * v0[0] + v0[1] * v0[1]) + (v0[2] * v0[2] + v0[3] * v0[3])) + ((v1[0] * v1[0] + v1[1] * v1[1]) + (v1[2] * v1[2] + v1[3] * v1[3])); }
                if (ssp) { ss += __shfl_xor(ss, 16); ss += __shfl_xor(ss, 32); if (fq == 0) acc_add_fx(ssp + row, ss); } }
    }
};
struct EpiBf16S {
    static constexpr bool PERM = true, AFTER_DRAIN = false;
    bf16_t* O; int ldc; const u64acc* rss; float inv_k;
    __device__ __forceinline__ void operator()(const f32x4 (&acc)[2][2][4][2], const Unit& u, int wr, int wc, int fr, int fq) const {
        const int row0 = u.pm * BM + wr * 64 + fr, col0 = u.pn * BM + wc * 32 + 8 * fq;
        unsigned long long sq[2][4];
#pragma unroll
        for (int ai = 0; ai < 2; ++ai)
#pragma unroll
            for (int m = 0; m < 4; ++m) sq[ai][m] = rss[row0 + ai * HALF + m * 16];
#pragma unroll
        for (int ai = 0; ai < 2; ++ai)
#pragma unroll
            for (int m = 0; m < 4; ++m) { const int row = row0 + ai * HALF + m * 16; bf16_t* rowp = O + (size_t)row * ldc + col0;
                const float s = rsqrtf((float)((double)sq[ai][m] * (1.0 / 16777216.0)) * inv_k + 1e-6f);
#pragma unroll
                for (int bj = 0; bj < 2; ++bj) { const f32x4 v0 = acc[ai][bj][m][0] * s, v1 = acc[ai][bj][m][1] * s;
                    u32x4 w; w.x = cvt_pk_bf16(v0[0], v0[1]); w.y = cvt_pk_bf16(v0[2], v0[3]); w.z = cvt_pk_bf16(v1[0], v1[1]); w.w = cvt_pk_bf16(v1[2], v1[3]);
                    *(u32x4*)(rowp + bj * HALF) = w; } }
    }
};

template <class Epi, class Sched, bool STAMP = false>
__device__ __forceinline__ void gemm_phase(PG8_LAS unsigned char* lds, const Gemm g, const Sched& S, const Epi& E, unsigned long long* stamps) {
    const int tid = threadIdx.x, wid = __builtin_amdgcn_readfirstlane(tid >> 6), lane = tid & 63, wr = wid >> 2, wc = wid & 3, fr = lane & 15, fq = lane >> 4;
    const int K = g.K, nt = K / BK;
    int ts_lo = 0, ts_hi = 0, nts = 0; const unsigned long long rt_entry = STAMP ? (unsigned long long)wall_clock64() : 0ull;
#define PG8_STAMP() do { if (STAMP && wid == 0 && nts < 64) { const unsigned long long _c = (unsigned long long)clock64(); \
        ts_lo = (lane == nts) ? (int)(unsigned)_c : ts_lo; ts_hi = (lane == nts) ? (int)(unsigned)(_c >> 32) : ts_hi; ++nts; } } while (0)
    PG8_STAMP();
    unsigned voffA[2], voffB[2];
#pragma unroll
    for (int i = 0; i < 2; ++i) { int R, C; stage_rc(tid * 16 + i * 8192, R, C); const int Rb = Epi::PERM ? ((R & ~31) + perm32(R & 31)) : R;
        voffA[i] = (unsigned)(R * K + C) * 2u; voffB[i] = (unsigned)(Rb * K + C) * 2u; }
    const size_t kstep = (size_t)(BK * 2);
    const size_t hstep = (size_t)HALF * K * 2;
    const size_t tstep = 2 * hstep;
    const unsigned ldsw = (unsigned)wid * 1024u;
    const int aoff = lds_byte(wr * 64 + fr, fq * 8), boff = lds_byte(wc * 32 + fr, fq * 8);
#define PG8_SA(b, h) (((b) * 2 + (h)) * HTB)
#define PG8_SB(b, h) ((4 + (b) * 2 + (h)) * HTB)
#define PG8_STAGE(bufoff, gbase, voff) do { _Pragma("unroll") for (int _i = 0; _i < 2; ++_i) \
        __builtin_amdgcn_global_load_lds((const unsigned*)((const char*)(gbase) + (voff)[_i]), (PG8_LAS unsigned*)(lds + (bufoff) + ldsw + _i * 8192), 16, 0, 0); } while (0)
#define PG8_LDA(dst, b, h) do { _Pragma("unroll") for (int m = 0; m < 4; ++m) _Pragma("unroll") for (int k = 0; k < 2; ++k) dst[m][k] = *(const PG8_LAS bf16x8*)(lds + PG8_SA(b, h) + aoff + m * 2048 + k * 1024); } while (0)
#define PG8_LDB(dst, b, h) do { _Pragma("unroll") for (int n = 0; n < 2; ++n) _Pragma("unroll") for (int k = 0; k < 2; ++k) dst[n][k] = *(const PG8_LAS bf16x8*)(lds + PG8_SB(b, h) + boff + n * 2048 + k * 1024); } while (0)
#define PG8_MMA(ai, bj, At, Bt) do { __builtin_amdgcn_s_setprio(1); _Pragma("unroll") for (int m = 0; m < 4; ++m) _Pragma("unroll") for (int n = 0; n < 2; ++n) _Pragma("unroll") for (int k = 0; k < 2; ++k) \
        acc[ai][bj][m][n] = __builtin_amdgcn_mfma_f32_16x16x32_bf16(Bt[n][k], At[m][k], acc[ai][bj][m][n], 0, 0, 0); __builtin_amdgcn_s_setprio(0); } while (0)
#define PG8_WAIT_V(n) asm volatile("s_waitcnt vmcnt(" #n ")" ::: "memory")
#define PG8_WAIT_L(n) asm volatile("s_waitcnt lgkmcnt(" #n ")" ::: "memory")
#define PG8_BAR __builtin_amdgcn_s_barrier()
#define PG8_SCHED __builtin_amdgcn_sched_barrier(0)
    Unit cur, nxt; int ui = 0;
    if (!S.next(0, cur)) return;
    f32x4 acc[2][2][4][2];
#pragma unroll
    for (int a = 0; a < 2; ++a)
#pragma unroll
        for (int b = 0; b < 2; ++b)
#pragma unroll
            for (int m = 0; m < 4; ++m)
#pragma unroll
                for (int n = 0; n < 2; ++n) acc[a][b][m][n] = (f32x4){0.f, 0.f, 0.f, 0.f};
    bf16x8 At[4][2], B0[2][2], B1[2][2];
    const char* cA = (const char*)g.A + (size_t)cur.pm * tstep; const char* cB = (const char*)g.Bt + (size_t)cur.pn * tstep;
    S.a_ready(cur);
    PG8_STAGE(PG8_SB(0, 0), cB, voffB); PG8_STAGE(PG8_SA(0, 0), cA, voffA); PG8_STAGE(PG8_SB(0, 1), cB + hstep, voffB); PG8_STAGE(PG8_SA(0, 1), cA + hstep, voffA);
    if (wr == 1) PG8_BAR;
    PG8_WAIT_V(4); PG8_BAR;
    PG8_STAGE(PG8_SB(1, 0), cB + kstep, voffB); PG8_STAGE(PG8_SA(1, 0), cA + kstep, voffA); PG8_STAGE(PG8_SB(1, 1), cB + hstep + kstep, voffB);
    PG8_WAIT_V(6); PG8_BAR;
    PG8_STAMP();
    for (;;) {
        const bool has_next = S.next(ui + 1, nxt);
        const char* nA = has_next ? (const char*)g.A + (size_t)nxt.pm * tstep : cA; const char* nB = has_next ? (const char*)g.Bt + (size_t)nxt.pn * tstep : cB;
        for (int t = 0; t < nt; t += 2) {
            const bool last = (t == nt - 2);
            const char* a1 = cA + (size_t)(t + 1) * kstep;
            const char* a2 = last ? nA : cA + (size_t)(t + 2) * kstep; const char* b2 = last ? nB : cB + (size_t)(t + 2) * kstep;
            const char* a3 = a2 + kstep; const char* b3 = b2 + kstep;
            if (last && has_next) S.a_ready(nxt);
            PG8_LDB(B0, 0, 0); PG8_SCHED; PG8_LDA(At, 0, 0); PG8_STAGE(PG8_SA(1, 1), a1 + hstep, voffA);
            PG8_WAIT_L(8); PG8_BAR; PG8_WAIT_L(0); PG8_MMA(0, 0, At, B0); PG8_BAR; PG8_SCHED;
            PG8_LDB(B1, 0, 1); PG8_STAGE(PG8_SB(0, 0), b2, voffB);
            PG8_BAR; PG8_WAIT_L(0); PG8_MMA(0, 1, At, B1); PG8_BAR;
            PG8_LDA(At, 0, 1); PG8_STAGE(PG8_SA(0, 0), a2, voffA);
            PG8_BAR; PG8_WAIT_L(0); PG8_MMA(1, 0, At, B0); PG8_BAR; PG8_SCHED;
            PG8_STAGE(PG8_SB(0, 1), b2 + hstep, voffB);
            PG8_WAIT_V(6); PG8_BAR; PG8_MMA(1, 1, At, B1); PG8_BAR;
            PG8_LDB(B0, 1, 0); PG8_SCHED; PG8_LDA(At, 1, 0); PG8_STAGE(PG8_SA(0, 1), a2 + hstep, voffA);
            PG8_WAIT_L(8); PG8_BAR; PG8_WAIT_L(0); PG8_MMA(0, 0, At, B0); PG8_BAR; PG8_SCHED;
            PG8_LDB(B1, 1, 1); PG8_STAGE(PG8_SB(1, 0), b3, voffB);
            PG8_BAR; PG8_WAIT_L(0); PG8_MMA(0, 1, At, B1); PG8_BAR;
            PG8_LDA(At, 1, 1); PG8_STAGE(PG8_SA(1, 0), a3, voffA);
            PG8_BAR; PG8_WAIT_L(0); PG8_MMA(1, 0, At, B0); PG8_BAR; PG8_SCHED;
            PG8_STAGE(PG8_SB(1, 1), b3 + hstep, voffB);
            PG8_WAIT_V(6); PG8_BAR; PG8_MMA(1, 1, At, B1); PG8_BAR;
        }
        PG8_STAMP();
        if constexpr (!Epi::AFTER_DRAIN) { E(acc, cur, wr, wc, fr, fq); S.done(cur); }
        PG8_STAMP();
        if (!has_next) break;
#pragma unroll
        for (int a = 0; a < 2; ++a)
#pragma unroll
            for (int b = 0; b < 2; ++b)
#pragma unroll
                for (int m = 0; m < 4; ++m)
#pragma unroll
                    for (int n = 0; n < 2; ++n) acc[a][b][m][n] = (f32x4){0.f, 0.f, 0.f, 0.f};
        cur = nxt; cA = nA; cB = nB; ++ui;
    }
    PG8_WAIT_V(0);
    if (wr == 0) PG8_BAR;
    PG8_BAR;
    if constexpr (Epi::AFTER_DRAIN) { E.fused(acc, cur, wr, wc, fr, fq, lds, wid, lane); S.done(cur); }
    PG8_STAMP();
    if (STAMP && wid == 0) { stamps[lane] = lane < nts ? (((unsigned long long)(unsigned)ts_hi << 32) | (unsigned)ts_lo) : 0ull;
        if (lane == 62) stamps[62] = rt_entry; if (lane == 63) stamps[63] = (unsigned long long)wall_clock64(); }
#undef PG8_STAMP
#undef PG8_SA
#undef PG8_SB
#undef PG8_STAGE
#undef PG8_LDA
#undef PG8_LDB
#undef PG8_MMA
#undef PG8_WAIT_V
#undef PG8_WAIT_L
#undef PG8_BAR
#undef PG8_SCHED
}
}

__device__ __forceinline__ void conv_wT(const float* __restrict__ W, bf16_t* __restrict__ Wt, int K, int N, unsigned char* lds) {
    const int tid = threadIdx.x;
    const int nkt = K / 128, nnt = (N + 63) / 64;
    bf16_t* T = (bf16_t*)lds;
    const int lr = tid >> 4, lc = (tid & 15) * 4;
    const int sn = tid >> 3, sk = (tid & 7) * 16;
    for (int tile = blockIdx.x; tile < nkt * nnt; tile += gridDim.x) {
        const int kt = tile % nkt, nt = tile / nkt;
        const int k0 = kt * 128, n0 = nt * 64;
#pragma unroll
        for (int i = 0; i < 4; ++i) {
            const int k = lr + 32 * i;
            f32x4 v = {0.f, 0.f, 0.f, 0.f};
            if (n0 + lc < N) v = *(const f32x4*)(W + (size_t)(k0 + k) * N + n0 + lc);
#pragma unroll
            for (int j = 0; j < 4; ++j) T[(lc + j) * 136 + k] = f2bf(v[j]);
        }
        __syncthreads();
        if (n0 + sn < N) {
            const u32x4 a = *(const u32x4*)(T + sn * 136 + sk), b = *(const u32x4*)(T + sn * 136 + sk + 8);
            *(u32x4*)(Wt + (size_t)(n0 + sn) * K + k0 + sk) = a; *(u32x4*)(Wt + (size_t)(n0 + sn) * K + k0 + sk + 8) = b;
        }
        __syncthreads();
    }
}


namespace fa {
typedef short bf16x8 __attribute__((ext_vector_type(8)));
typedef short s16x4 __attribute__((ext_vector_type(4)));
typedef float f32x16 __attribute__((ext_vector_type(16)));
#define FA_SBAR() __builtin_amdgcn_sched_barrier(0)
constexpr float LOG2E = 1.4426950408889634f;
#define FA_PD 3
constexpr float THR_NAT = 8.f;
__device__ __forceinline__ int crow(int r, int hi) { return (r & 3) + 8 * (r >> 2) + 4 * hi; }
__device__ __forceinline__ unsigned cvtpk(float lo, float hi) { unsigned r; asm volatile("v_cvt_pk_bf16_f32 %0, %1, %2" : "=v"(r) : "v"(lo), "v"(hi)); return r; }
template <int DK> __device__ __forceinline__ int kswz(int row, int colB) { return row * (DK * 2) + (colB ^ ((DK == 128 ? (row & 15) : (row & 7)) << 4)); }
__device__ __forceinline__ int v_st(int k, int c) { const int kk = (k & ~0xC) | ((k & 4) << 1) | ((k & 8) >> 1); return ((kk >> 3) * 4 + (c >> 5)) * 512 + ((kk & 7) * 32 + (c & 31)) * 2; }
__device__ __forceinline__ int v_rd_base(int lane) { return ((lane & 3) << 3) | (((lane >> 2) & 3) << 6) | (((lane >> 4) & 1) << 5) | (((lane >> 5) & 1) << 8); }
constexpr int v_rd_off(int d0, int ks, int half) { return d0 * 512 + ks * 4096 + half * 2048; }
template <int OFF> __device__ __forceinline__ s16x4 tr_read(int vb) {
    s16x4 r; asm volatile("ds_read_b64_tr_b16 %0, %1 offset:%2" : "=&v"(r) : "v"(vb), "i"(OFF) : "memory"); return r;
}
template <int D0> __device__ __forceinline__ void pv_rd(int vb, s16x4 (&v)[8]) {
    v[0] = tr_read<v_rd_off(D0, 0, 0)>(vb); v[1] = tr_read<v_rd_off(D0, 0, 1)>(vb); v[2] = tr_read<v_rd_off(D0, 1, 0)>(vb); v[3] = tr_read<v_rd_off(D0, 1, 1)>(vb);
    v[4] = tr_read<v_rd_off(D0, 2, 0)>(vb); v[5] = tr_read<v_rd_off(D0, 2, 1)>(vb); v[6] = tr_read<v_rd_off(D0, 3, 0)>(vb); v[7] = tr_read<v_rd_off(D0, 3, 1)>(vb);
}
__device__ __forceinline__ void pv_mm(f32x16& od, const s16x4 (&v)[8], bf16x8 pa0, bf16x8 pa1, bf16x8 pa2, bf16x8 pa3) {
#define FA_PK(L, H) (bf16x8){L[0], L[1], L[2], L[3], H[0], H[1], H[2], H[3]}
    od = __builtin_amdgcn_mfma_f32_32x32x16_bf16(pa0, FA_PK(v[0], v[1]), od, 0, 0, 0);
    od = __builtin_amdgcn_mfma_f32_32x32x16_bf16(pa1, FA_PK(v[2], v[3]), od, 0, 0, 0);
    od = __builtin_amdgcn_mfma_f32_32x32x16_bf16(pa2, FA_PK(v[4], v[5]), od, 0, 0, 0);
    od = __builtin_amdgcn_mfma_f32_32x32x16_bf16(pa3, FA_PK(v[6], v[7]), od, 0, 0, 0);
#undef FA_PK
}
__device__ __forceinline__ void pv_d0(f32x16* o, int vb, bf16x8 pa0, bf16x8 pa1, bf16x8 pa2, bf16x8 pa3) {
    s16x4 A[8], B[8];
    pv_rd<0>(vb, A); pv_rd<1>(vb, B);
    asm volatile("s_waitcnt lgkmcnt(8)" ::: "memory"); FA_SBAR();
    pv_mm(o[0], A, pa0, pa1, pa2, pa3); FA_SBAR();
    pv_rd<2>(vb, A);
    asm volatile("s_waitcnt lgkmcnt(8)" ::: "memory"); FA_SBAR();
    pv_mm(o[1], B, pa0, pa1, pa2, pa3); FA_SBAR();
    pv_rd<3>(vb, B);
    asm volatile("s_waitcnt lgkmcnt(8)" ::: "memory"); FA_SBAR();
    pv_mm(o[2], A, pa0, pa1, pa2, pa3); FA_SBAR();
    asm volatile("s_waitcnt lgkmcnt(0)" ::: "memory"); FA_SBAR();
    pv_mm(o[3], B, pa0, pa1, pa2, pa3);
}
__device__ __forceinline__ void pack_p(const f32x16& p0, const f32x16& p1, bf16x8& pa0, bf16x8& pa1, bf16x8& pa2, bf16x8& pa3) {
#define FA_PK4(P, BASE, OUT) do { unsigned a0 = cvtpk(P[BASE + 0], P[BASE + 1]), a1 = cvtpk(P[BASE + 2], P[BASE + 3]);   \
    unsigned b0 = cvtpk(P[BASE + 4], P[BASE + 5]), b1 = cvtpk(P[BASE + 6], P[BASE + 7]);                              \
    auto r0 = __builtin_amdgcn_permlane32_swap(a0, b0, false, false); auto r1 = __builtin_amdgcn_permlane32_swap(a1, b1, false, false); \
    u32x4 w = {r0[0], r1[0], r0[1], r1[1]}; OUT = *reinterpret_cast<bf16x8*>(&w); } while (0)
    FA_PK4(p0, 0, pa0); FA_PK4(p0, 8, pa1); FA_PK4(p1, 0, pa2); FA_PK4(p1, 8, pa3);
#undef FA_PK4
}
__device__ __forceinline__ float pair_max(float v) { auto rr = __builtin_amdgcn_permlane32_swap(__float_as_uint(v), __float_as_uint(v), false, false); return fmaxf(__uint_as_float(rr[0]), __uint_as_float(rr[1])); }
__device__ __forceinline__ float pair_sum(float v) { auto rr = __builtin_amdgcn_permlane32_swap(__float_as_uint(v), __float_as_uint(v), false, false); return __uint_as_float(rr[0]) + __uint_as_float(rr[1]); }

template <int DK, int NKB = 2, int NVB = NKB> struct LdsMap { static constexpr int KB = 64 * DK * 2, VB = 64 * 128 * 2, K0 = 0, V0 = NKB * KB, WS0 = NKB * KB + NVB * VB, TOTAL = WS0 + 8 * 256; };
template <class P> using PolLds = LdsMap<P::DK, P::SKEW ? 2 : P::RING, P::SKEW ? 3 : P::RING>;

template <class P>
__device__ __forceinline__ void flash_pass(const P& pol, unsigned char* lds, const bf16x8 (&qr)[P::DK / 16], f32x16 (&o)[4], float& m_reg, float& l_reg, int* kt_last = nullptr) {
    constexpr int DK = P::DK, RING = P::RING; using L = PolLds<P>;
    constexpr float C = P::SCALE * LOG2E, THR_RAW = THR_NAT / P::SCALE;
    int tid = threadIdx.x; asm volatile("" : "+v"(tid));
    const int wid = tid >> 6, lane = tid & 63, r32 = lane & 31, hi = lane >> 5;
    const int widu = __builtin_amdgcn_readfirstlane((int)threadIdx.x >> 6);
    unsigned char* Kl = lds + L::K0; unsigned char* Vl = lds + L::V0;
    float* al_l = (float*)(lds + L::WS0) + wid * 64 + 32;
    const int vb0 = (int)(uintptr_t)Vl + v_rd_base(lane);
    const int ka0 = (int)(uintptr_t)Kl + r32 * (DK * 2) + (((DK == 128 ? (r32 & 15) : (r32 & 7)) << 4) ^ (hi << 4));
    bf16x8 kg0 = {}, kg1 = {};
    if constexpr (P::AUG) { if (hi == 0) { const short a = (short)f2bf((float)r32), b = (short)f2bf((float)(32 + r32)); kg0[0] = a; kg0[1] = a; kg0[2] = (short)0x3F80; kg1[0] = b; kg1[1] = b; kg1[2] = (short)0x3F80; } }
    constexpr int NW = P::SKEW ? 4 : 8;
    constexpr int NKI = DK / 8 / NW, NVI = 16 / NW, NI = NKI + NVI;
    const char* kbase = (const char*)pol.kptr(0, 0); { const char* k2 = (const char*)pol.kptr(0, DK == 192 ? 16 : 0); kbase = k2 < kbase ? k2 : kbase; }
    const char* vbase = (const char*)pol.vptr(0, 0);
    unsigned kof[NKI], kst[NKI], vof[NVI], vst[NVI];
    const int wq = wid & (NW - 1), wqu = widu & (NW - 1);
#pragma unroll
    for (int i = 0; i < NKI; ++i) { const int n = (i * NW + wq) * 64 + lane, row = n / (DK / 8), slot = n % (DK / 8), cg = slot ^ (DK == 128 ? (row & 15) : (row & 7));
        const char* a = (const char*)pol.kptr(row, cg); kof[i] = (unsigned)(a - kbase); kst[i] = (unsigned)((const char*)pol.kptr(64 + row, cg) - a); }
#pragma unroll
    for (int i = 0; i < NVI; ++i) { const int sub = (i * NW + wq) * 2 + (lane >> 5), kk = (sub >> 2) * 8 + ((lane & 31) >> 2), key = (kk & ~0xC) | ((kk & 4) << 1) | ((kk & 8) >> 1), cg = (sub & 3) * 4 + (lane & 3);
        const char* a = (const char*)pol.vptr(key, cg); vof[i] = (unsigned)(a - vbase); vst[i] = (unsigned)((const char*)pol.vptr(64 + key, cg) - a); }
    const int kld = (int)(uintptr_t)Kl + wqu * 1024, vld = (int)(uintptr_t)Vl + wqu * 1024;
#define FA_DMA(kt, kb, vb) do { const unsigned kt_ = (unsigned)(kt); \
        _Pragma("unroll") for (int i_ = 0; i_ < NKI; ++i_) __builtin_amdgcn_global_load_lds((const unsigned*)(kbase + (size_t)(__umul24(kt_, kst[i_]) + kof[i_])), (LAS unsigned*)(unsigned)(kld + (kb) * L::KB + i_ * (NW * 1024)), 16, 0, 0); \
        _Pragma("unroll") for (int i_ = 0; i_ < NVI; ++i_) __builtin_amdgcn_global_load_lds((const unsigned*)(vbase + (size_t)(__umul24(kt_, vst[i_]) + vof[i_])), (LAS unsigned*)(unsigned)(vld + (vb) * L::VB + i_ * (NW * 1024)), 16, 0, 0); } while (0)
#define FA_WAITV_NI() do { if constexpr (NI == 4) asm volatile("s_waitcnt vmcnt(4)" ::: "memory"); else asm volatile("s_waitcnt vmcnt(5)" ::: "memory"); } while (0)
#define FA_WAITV0() asm volatile("s_waitcnt vmcnt(0)" ::: "memory")
#define FA_LBAR() do { asm volatile("s_waitcnt lgkmcnt(0)" ::: "memory"); __builtin_amdgcn_s_barrier(); asm volatile("" ::: "memory"); } while (0)
#define FA_ALLDONE(par) ({ const u32x4 fa_ = *(volatile LAS u32x4*)(flags + (par) * 8), fb_ = *(volatile LAS u32x4*)(flags + (par) * 8 + 4); (fa_.x & fa_.y & fa_.z & fa_.w & fb_.x & fb_.y & fb_.z & fb_.w) != 0u; })
    LAS int* flags = (LAS int*)(lds + L::TOTAL);
    f32x16 p0, p1; float tbias;
    auto qk = [&](int kt_, int ks_) __attribute__((always_inline)) {
        p0 = f32x16{}; p1 = f32x16{};
        {
            int ka = ka0 + ks_ * L::KB; asm volatile("" : "+v"(ka));
            constexpr int NS = DK / 16, XM = (DK == 128 ? 7 : 3), XS = (DK == 128 ? 3 : 2);
#define FA_KF(d, half) (*(const LAS bf16x8*)(unsigned)((ka ^ (((d) & XM) << 5)) + ((d) >> XS) * 128 + (half) * (32 * DK * 2)))
            bf16x8 fb0[FA_PD], fb1[FA_PD];
#pragma unroll
            for (int d0 = 0; d0 < FA_PD - 1; ++d0) { fb0[d0] = FA_KF(d0, 0); fb1[d0] = FA_KF(d0, 1); }
#pragma unroll
            for (int d0 = 0; d0 < NS; ++d0) {
                if (d0 + FA_PD - 1 < NS) { fb0[(d0 + FA_PD - 1) % FA_PD] = FA_KF(d0 + FA_PD - 1, 0); fb1[(d0 + FA_PD - 1) % FA_PD] = FA_KF(d0 + FA_PD - 1, 1); }
                FA_SBAR();
                p0 = __builtin_amdgcn_mfma_f32_32x32x16_bf16(fb0[d0 % FA_PD], qr[d0], p0, 0, 0, 0);
                p1 = __builtin_amdgcn_mfma_f32_32x32x16_bf16(fb1[d0 % FA_PD], qr[d0], p1, 0, 0, 0);
                FA_SBAR();
            }
#undef FA_KF
        }
        tbias = 0.f;
        if constexpr (P::AUG) {
            const bf16x8 qa = pol.qaug(kt_, hi);
            p0 = __builtin_amdgcn_mfma_f32_32x32x16_bf16(kg0, qa, p0, 0, 0, 0);
            p1 = __builtin_amdgcn_mfma_f32_32x32x16_bf16(kg1, qa, p1, 0, 0, 0);
            tbias = pol.tile_bias(kt_);
        }
        if (pol.need_mask(kt_)) {
            const int kb = kt_ * 64;
            const unsigned ts = pol.tile_state(kt_);
#pragma unroll
            for (int r = 0; r < 16; ++r) { p0[r] = pol.score(p0[r], kb + crow(r, hi), ts); p1[r] = pol.score(p1[r], kb + 32 + crow(r, hi), ts); }
        }
    };
    auto smpv = [&](int vs_) __attribute__((always_inline)) {
        float pmax = p0[0];
#pragma unroll
        for (int r = 1; r < 16; ++r) pmax = fmaxf(pmax, p0[r]);
#pragma unroll
        for (int r = 0; r < 16; ++r) pmax = fmaxf(pmax, p1[r]);
        pmax = pair_max(pmax) + tbias;
        float mn, alpha;
        if (__builtin_expect(__all(pmax - m_reg <= THR_RAW), 1)) { mn = m_reg; alpha = 1.f; }
        else { mn = fmaxf(m_reg, pmax); alpha = __builtin_amdgcn_exp2f((m_reg - mn) * C); m_reg = mn; }
        const float mnC = (tbias - mn) * C;
#pragma unroll
        for (int r = 0; r < 16; ++r) { p0[r] = __builtin_amdgcn_exp2f(fmaf(p0[r], C, mnC)); p1[r] = __builtin_amdgcn_exp2f(fmaf(p1[r], C, mnC)); }
        float ps = 0.f;
#pragma unroll
        for (int r = 0; r < 16; ++r) ps += p0[r];
#pragma unroll
        for (int r = 0; r < 16; ++r) ps += p1[r];
        ps = pair_sum(ps);
        l_reg = l_reg * alpha + ps;
        if (__any(alpha < 1.f)) {
            if (hi == 0) al_l[r32] = alpha;
            asm volatile("s_waitcnt lgkmcnt(0)" ::: "memory");
#pragma unroll
            for (int r = 0; r < 16; ++r) { const float f = al_l[crow(r, hi)];
#pragma unroll
                for (int d = 0; d < 4; ++d) o[d][r] *= f; }
        }
        bf16x8 pa0, pa1, pa2, pa3;
        pack_p(p0, p1, pa0, pa1, pa2, pa3);
        pv_d0(o, vb0 + vs_ * L::VB, pa0, pa1, pa2, pa3);
    };
    int kt = pol.first_tile();
    bool wdone = false;
    int nk = pol.next_tile(kt);
    if constexpr (!P::SKEW) {
        FA_DMA(kt, 0, 0);
        if constexpr (RING == 3) { if (nk >= 0) { FA_DMA(nk, 1, 1); FA_WAITV_NI(); } else FA_WAITV0(); } else FA_WAITV0();
        FA_LBAR();
        int cur = 0;
        for (int it = 0;; ++it) {
            int nk2 = -1;
            if constexpr (RING == 3) { nk2 = nk >= 0 ? pol.next_tile(nk) : -1; if (nk2 >= 0) FA_DMA(nk2, (cur == 0 ? 2 : cur - 1), (cur == 0 ? 2 : cur - 1)); }
            else { if (nk >= 0) FA_DMA(nk, cur ^ 1, cur ^ 1); }
            if (!wdone && !pol.wave_skip(kt)) { qk(kt, cur); smpv(cur); }
            const int par = it & 1;
            if constexpr (P::STOP) {
                if (nk >= 0) { if (!wdone) wdone = pol.wave_done(nk, m_reg); if (lane == 0) *(volatile LAS int*)(flags + par * 8 + wid) = wdone ? 1 : 0; }
            }
            if (nk >= 0) { if (RING == 3 && nk2 >= 0) FA_WAITV_NI(); else FA_WAITV0(); }
            FA_LBAR();
            if (nk < 0) break;
            if constexpr (P::STOP) { if (FA_ALLDONE(par)) break; }
            kt = nk;
            if constexpr (RING == 3) { nk = nk2; cur = (cur == 2 ? 0 : cur + 1); } else { nk = pol.next_tile(kt); cur ^= 1; }
        }
        if constexpr (P::STOP) { FA_WAITV0(); FA_LBAR(); }
    } else {
        const bool h1 = widu < 4;
        if (!h1) FA_DMA(kt, 0, 0);
        FA_WAITV0(); FA_LBAR();
        int cur = 0, vcur = 0;
        if (!h1) {
            for (int it = 0;; ++it) {
                const int vnx = vcur == 2 ? 0 : vcur + 1, par = it & 1;
                if (nk >= 0) FA_DMA(nk, cur ^ 1, vnx);
                if (!wdone && !pol.wave_skip(kt)) { qk(kt, cur); smpv(vcur); }
                if constexpr (P::STOP) { if (nk >= 0) { if (!wdone) wdone = pol.wave_done(nk, m_reg); if (lane == 0) *(volatile LAS int*)(flags + par * 8 + wid) = wdone ? 1 : 0; } }
                FA_WAITV0(); FA_LBAR();
                if (nk < 0) break;
                if constexpr (P::STOP) { if (FA_ALLDONE(par)) break; }
                kt = nk; nk = pol.next_tile(kt); cur ^= 1; vcur = vnx;
            }
        } else {
            bool pend = false; int vprev = 0;
            for (int it = 0;; ++it) {
                const int vnx = vcur == 2 ? 0 : vcur + 1, par = it & 1;
                if (pend) smpv(vprev);
                if constexpr (P::STOP) { if (!wdone) wdone = pol.wave_done(kt, m_reg); if (lane == 0) *(volatile LAS int*)(flags + par * 8 + wid) = wdone ? 1 : 0; }
                pend = !wdone && !pol.wave_skip(kt);
                if (pend) qk(kt, cur);
                vprev = vcur;
                FA_WAITV0(); FA_LBAR();
                if (nk < 0) break;
                if constexpr (P::STOP) { if (FA_ALLDONE(par)) break; }
                kt = nk; nk = pol.next_tile(kt); cur ^= 1; vcur = vnx;
            }
            if (pend) smpv(vprev);
        }
        FA_WAITV0(); FA_LBAR();
    }
    if (kt_last) *kt_last = kt;
#undef FA_DMA
#undef FA_WAITV_NI
#undef FA_WAITV0
#undef FA_LBAR
#undef FA_ALLDONE
}
__device__ __forceinline__ void row_inv_l(unsigned char* lds_ws, float l_reg, float (&rli)[16]) {
    const int tid = threadIdx.x, wid = tid >> 6, lane = tid & 63, r32 = lane & 31, hi = lane >> 5;
    float* li_l = (float*)lds_ws + wid * 64;
    if (hi == 0) li_l[r32] = l_reg;
    asm volatile("s_waitcnt lgkmcnt(0)" ::: "memory");
#pragma unroll
    for (int r = 0; r < 16; ++r) { const float l = li_l[crow(r, hi)]; rli[r] = l > 0.f ? __builtin_amdgcn_rcpf(l) : 0.f; }
}
__device__ __forceinline__ void row_factor(unsigned char* lds_ws, float f, float (&fr)[16]) {
    const int tid = threadIdx.x, wid = tid >> 6, lane = tid & 63, r32 = lane & 31, hi = lane >> 5;
    float* li_l = (float*)lds_ws + wid * 64;
    if (hi == 0) li_l[r32] = f;
    asm volatile("s_waitcnt lgkmcnt(0)" ::: "memory");
#pragma unroll
    for (int r = 0; r < 16; ++r) fr[r] = li_l[crow(r, hi)];
    asm volatile("s_waitcnt lgkmcnt(0)" ::: "memory");
}
template <int DK> __device__ __forceinline__ void load_q(const bf16_t* qrow, int hi, bf16x8 (&qr)[DK / 16]) {
#pragma unroll
    for (int d0 = 0; d0 < DK / 16; ++d0) qr[d0] = *(const bf16x8*)(qrow + d0 * 16 + hi * 8);
}

__device__ __forceinline__ void norm_q128(bf16x8 (&qr)[8], const float* __restrict__ g, int hi) {
    float ss = 0.f;
#pragma unroll
    for (int d0 = 0; d0 < 8; ++d0)
#pragma unroll
        for (int e = 0; e < 8; ++e) { const float f = __uint_as_float(((unsigned)(unsigned short)qr[d0][e]) << 16); ss += f * f; }
    ss = pair_sum(ss);
    const float r = rsqrtf(ss * (1.f / 128.f) + 1e-6f);
#pragma unroll
    for (int d0 = 0; d0 < 8; ++d0) { const f32x4 g0 = *(const f32x4*)(g + d0 * 16 + hi * 8), g1 = *(const f32x4*)(g + d0 * 16 + hi * 8 + 4);
        float f[8];
#pragma unroll
        for (int e = 0; e < 8; ++e) f[e] = __uint_as_float(((unsigned)(unsigned short)qr[d0][e]) << 16) * r;
        u32x4 w; w.x = cvtpk(f[0] * g0[0], f[1] * g0[1]); w.y = cvtpk(f[2] * g0[2], f[3] * g0[3]); w.z = cvtpk(f[4] * g1[0], f[5] * g1[1]); w.w = cvtpk(f[6] * g1[2], f[7] * g1[3]);
        qr[d0] = *reinterpret_cast<bf16x8*>(&w); }
}
__device__ __forceinline__ float bfv(short v) { return __uint_as_float(((unsigned)(unsigned short)v) << 16); }
__device__ __forceinline__ void norm_q_mla(bf16x8 (&qr)[12], const float* __restrict__ qn, const float* __restrict__ rope, int tok, int hi) {
    float ssn = 0.f, ssr = 0.f;
#pragma unroll
    for (int d0 = 0; d0 < 8; ++d0)
#pragma unroll
        for (int e = 0; e < 8; ++e) { const float f = bfv(qr[d0][e]); ssn += f * f; }
#pragma unroll
    for (int d0 = 8; d0 < 12; ++d0)
#pragma unroll
        for (int e = 0; e < 8; ++e) { const float f = bfv(qr[d0][e]); ssr += f * f; }
    ssn = pair_sum(ssn); ssr = pair_sum(ssr);
    const float rn = rsqrtf(ssn * (1.f / 128.f) + 1e-6f), rr = rsqrtf(ssr * (1.f / 64.f) + 1e-6f);
#pragma unroll
    for (int d0 = 0; d0 < 8; ++d0) { const f32x4 g0 = *(const f32x4*)(qn + d0 * 16 + hi * 8), g1 = *(const f32x4*)(qn + d0 * 16 + hi * 8 + 4);
        u32x4 w; w.x = cvtpk(bfv(qr[d0][0]) * rn * g0[0], bfv(qr[d0][1]) * rn * g0[1]); w.y = cvtpk(bfv(qr[d0][2]) * rn * g0[2], bfv(qr[d0][3]) * rn * g0[3]);
        w.z = cvtpk(bfv(qr[d0][4]) * rn * g1[0], bfv(qr[d0][5]) * rn * g1[1]); w.w = cvtpk(bfv(qr[d0][6]) * rn * g1[2], bfv(qr[d0][7]) * rn * g1[3]);
        qr[d0] = *reinterpret_cast<bf16x8*>(&w); }
#pragma unroll
    for (int b = 0; b < 2; ++b) {
        const int i0 = b * 16 + hi * 8;
        float x1[8], x2[8];
#pragma unroll
        for (int e = 0; e < 8; ++e) { x1[e] = bfv(qr[8 + b][e]) * rr * qn[128 + i0 + e]; x2[e] = bfv(qr[10 + b][e]) * rr * qn[160 + i0 + e]; }
        const float* cs = rope + ((size_t)tok * 32 + i0) * 2;
        float o1[8], o2[8];
#pragma unroll
        for (int e = 0; e < 8; ++e) { const float c = cs[2 * e], s = cs[2 * e + 1]; o1[e] = x1[e] * c - x2[e] * s; o2[e] = x1[e] * s + x2[e] * c; }
        u32x4 w1, w2; w1.x = cvtpk(o1[0], o1[1]); w1.y = cvtpk(o1[2], o1[3]); w1.z = cvtpk(o1[4], o1[5]); w1.w = cvtpk(o1[6], o1[7]);
        w2.x = cvtpk(o2[0], o2[1]); w2.y = cvtpk(o2[2], o2[3]); w2.z = cvtpk(o2[4], o2[5]); w2.w = cvtpk(o2[6], o2[7]);
        qr[8 + b] = *reinterpret_cast<bf16x8*>(&w1); qr[10 + b] = *reinterpret_cast<bf16x8*>(&w2);
    }
}
struct AugC { short chi, clo; };
__device__ __forceinline__ AugC aug_split(float c) { const bf16_t h = f2bf(c); const bf16_t l = f2bf(c - bf2f(h)); return AugC{(short)h, (short)l}; }
__device__ __forceinline__ bf16x8 aug_q(AugC c, bool masked, int hi) { bf16x8 q = {}; if (hi == 0) { q[0] = c.chi; q[1] = c.clo; q[2] = masked ? (short)0xFF80 : (short)0; } return q; }

struct MlaPol {
    static constexpr int DK = 192; static constexpr float SCALE = 0.07216878364870322f; static constexpr bool AUG = false, STOP = false, SKEW = true; static constexpr int RING = 3;
    const bf16_t* KVU; const bf16_t* KR; int h; int t0w; int qpos; int kt_hi;
    __device__ __forceinline__ int first_tile() const { return 0; }
    __device__ __forceinline__ int next_tile(int kt) const { return kt < kt_hi ? kt + 1 : -1; }
    __device__ __forceinline__ const bf16_t* kptr(int key, int c) const { return c < 16 ? KVU + (size_t)key * 4096 + h * 256 + c * 8 : KR + (size_t)key * 64 + (c - 16) * 8; }
    __device__ __forceinline__ const bf16_t* vptr(int key, int c) const { return KVU + (size_t)key * 4096 + h * 256 + 128 + c * 8; }
    __device__ __forceinline__ bool wave_skip(int kt) const { return kt * 64 > t0w + 31; }
    __device__ __forceinline__ bool need_mask(int kt) const { return kt * 64 + 63 > t0w; }
    __device__ __forceinline__ unsigned tile_state(int) const { return 0u; }
    __device__ __forceinline__ float score(float s, int kpos, unsigned) const { return kpos <= qpos ? s : -INFINITY; }
};
__device__ __forceinline__ void mla_attn_phase(unsigned char* lds, const bf16_t* QU, const bf16_t* KVU, const bf16_t* KR, const bf16_t* PB, const float* qn, const float* rope, bf16_t* AO) {
    const int tid = threadIdx.x, wid = tid >> 6, lane = tid & 63, r32 = lane & 31, hi = lane >> 5;
    const int bx = blockIdx.x;
    const int h = (bx & 7) * 2 + ((bx >> 3) >> 4), j = (bx >> 3) & 15;
    for (int uu = 0; uu < 2; ++uu) {
        const int qb = uu == 0 ? 31 - j : j;
        const int t0w = qb * 256 + wid * 32;
        MlaPol pol{KVU, KR, h, t0w, t0w + r32, qb * 4 + 3};
        bf16x8 qr[12];
        load_q<192>(QU + (size_t)(t0w + r32) * 3072 + h * 192, hi, qr);
        norm_q_mla(qr, qn, rope, t0w + r32, hi);
        f32x16 o[4] = {}; float m_reg = -1e30f, l_reg = 0.f;
        flash_pass<MlaPol>(pol, lds, qr, o, m_reg, l_reg);
        float rli[16];
        row_inv_l(lds + PolLds<MlaPol>::WS0, l_reg, rli);
#pragma unroll
        for (int r = 0; r < 16; ++r) { const int tok = t0w + crow(r, hi);
            const bf16_t* g = PB + (size_t)tok * 3072 + 832 + h * 128; bf16_t* ao = AO + (size_t)tok * DM + h * 128;
#pragma unroll
            for (int d0 = 0; d0 < 4; ++d0) { const int col = d0 * 32 + r32; ao[col] = f2bf(o[d0][r] * rli[r] * silu_f(bf2f(g[col]))); } }
        __syncthreads();
    }
}

struct MobaPol {
    static constexpr int DK = 128; static constexpr float SCALE = 0.08838834764831845f; static constexpr bool AUG = true, STOP = true, SKEW = true; static constexpr int RING = 3;
    const bf16_t* PB; int h; int own; int t0w; int qpos; unsigned mask; float craw; AugC cc; float qkmax; int kt_first, kt_last; float m_lb;
    __device__ __forceinline__ int first_tile() const { return kt_first; }
    __device__ __forceinline__ int next_tile(int kt) const { return kt > kt_last ? kt - 1 : -1; }
    __device__ __forceinline__ const bf16_t* kptr(int key, int c) const { return PB + (size_t)key * 8192 + 2048 + h * 128 + c * 8; }
    __device__ __forceinline__ const bf16_t* vptr(int key, int c) const { return PB + (size_t)key * 8192 + 4096 + h * 128 + c * 8; }
    __device__ __forceinline__ bool wave_skip(int kt) const { const int b = kt >> 2; return b == own ? (kt * 64 > t0w + 31) : !__any((int)((mask >> b) & 1u)); }
    __device__ __forceinline__ bf16x8 qaug(int kt, int hi) const { return aug_q(cc, !((mask >> (kt >> 2)) & 1u), hi); }
    __device__ __forceinline__ float tile_bias(int kt) const { return craw * (float)(kt * 64 - own * 256); }
    __device__ __forceinline__ bool wave_done(int nk, float m) const { return __all((qkmax + craw * (float)(nk * 64 + 63 - own * 256) - fmaxf(m, m_lb)) * (SCALE * LOG2E) < -152.f); }
    __device__ __forceinline__ bool need_mask(int kt) const { return kt * 64 + 63 > t0w; }
    __device__ __forceinline__ unsigned tile_state(int) const { return 0u; }
    __device__ __forceinline__ float score(float s, int kpos, unsigned) const { return kpos <= qpos ? s : -INFINITY; }
};
__device__ __forceinline__ float max_abs128(const float* g, int lane) { float v = fmaxf(fabsf(g[lane]), fabsf(g[lane + 64])); return wave_max(v); }
__device__ __forceinline__ float bflo(short v) { return __uint_as_float(((unsigned)(unsigned short)v) << 16); }

constexpr int MOBA_UPH = 16 + 16 * 2, MOBA_NSPLIT = 10 * MOBA_UPH, MOBA_NUNITS = MOBA_NSPLIT + 6 * 32;
__device__ __forceinline__ void moba_unit(int ui, int& h, int& qb, int& part) {
    if (ui < MOBA_NSPLIT) { h = 15 - ui / MOBA_UPH; const int e = ui % MOBA_UPH; qb = e < 32 ? 31 - (e >> 1) : 47 - e; part = e < 32 ? (e & 1) : -1; }
    else { const int v = ui - MOBA_NSPLIT; h = 5 - (v >> 5); qb = 31 - (v & 31); part = -1; }
}
__device__ __forceinline__ int moba_est(int ui) {
    int h, qb, part; moba_unit(ui, h, qb, part);
    const int cut = (int)(115.f / (alibi_slope(h) * 64.f)) + 2;
    if (part < 0) { const int T = 4 * qb + 4; return T < cut ? T : cut; }
    const int T = 2 * qb + 2;
    if (part == 0) return T < cut ? T : cut;
    return cut > T ? (T < cut - T ? T : cut - T) : 1;
}
__device__ __forceinline__ int moba_sub(int ui) { int h, qb, part; moba_unit(ui, h, qb, part); return h >= 8 ? 15 - h : h; }
__device__ __forceinline__ int moba_sub_count(int x) { return 48 + (x >= 6 ? 48 : 32); }
__device__ __forceinline__ void moba_order_phase(int* order) {
    const int wid = threadIdx.x >> 6, lane = threadIdx.x & 63;
    for (int u = blockIdx.x * 8 + wid; u < MOBA_NUNITS; u += gridDim.x * 8) {
        const int eu = moba_est(u), xu = moba_sub(u); int cnt = 0;
        for (int v = lane; v < MOBA_NUNITS; v += 64) { const int ev = moba_est(v); cnt += (moba_sub(v) == xu && (ev > eu || (ev == eu && v < u))) ? 1 : 0; }
        for (int o = 32; o > 0; o >>= 1) cnt += __shfl_xor(cnt, o);
        if (lane == 0) order[xu * 96 + cnt] = u;
    }
}
__device__ __forceinline__ void moba_attn_phase(unsigned char* lds, const bf16_t* PB, const float* KPART, const float* qn, const float* kn, unsigned* ctr, unsigned* split,
                                                unsigned char* scratch, const int* order, bf16_t* AO) {
    const int tid = threadIdx.x, wid = tid >> 6, lane = tid & 63, r32 = lane & 31, hi = lane >> 5;
    const float qkmax = 128.f * 1.02f * max_abs128(qn, lane) * max_abs128(kn, lane);
    float* kml = (float*)(lds + PolLds<MobaPol>::TOTAL + 128);
    volatile LAS int* slot = (volatile LAS int*)(lds + PolLds<MobaPol>::TOTAL + 64);
    int hprev = -1;
    const int xq = (int)blockIdx.x & 7;
    for (;;) {
        if (tid == 0) *slot = (int)__hip_atomic_fetch_add(ctr + xq * 8, 1u, __ATOMIC_RELAXED, __HIP_MEMORY_SCOPE_AGENT);
        __syncthreads();
        const int ti = *slot;
        if (ti >= moba_sub_count(xq)) break;
        int h, qb, part;
        moba_unit(order[xq * 96 + ti], h, qb, part);
        const float slope = alibi_slope(h);
        if (h != hprev) {
            for (int idx = tid; idx < 32 * 128; idx += 512) { const int n = idx >> 7, d = idx & 127; float s = 0.f;
#pragma unroll
                for (int i = 0; i < 8; ++i) s += KPART[(size_t)(8 * n + i) * 2048 + h * 128 + d];
                kml[idx] = s * (1.f / 256.f); }
            hprev = h;
            __syncthreads();
        }
        const int t0w = qb * 256 + wid * 32;
        bf16x8 qr[8];
        load_q<128>(PB + (size_t)(t0w + r32) * 8192 + h * 128, hi, qr);
        norm_q128(qr, qn, hi);
        float b0 = -INFINITY, b1 = -INFINITY, b2 = -INFINITY; int i0 = 0, i1 = 0, i2 = 0;
        for (int n = 0; n < qb; ++n) {
            const float* km = kml + n * 128 + hi * 8;
            float s = 0.f;
#pragma unroll
            for (int d0 = 0; d0 < 8; ++d0) { const f32x4 ka = *(const f32x4*)(km + d0 * 16), kb = *(const f32x4*)(km + d0 * 16 + 4);
                s += bflo(qr[d0][0]) * ka[0] + bflo(qr[d0][1]) * ka[1] + bflo(qr[d0][2]) * ka[2] + bflo(qr[d0][3]) * ka[3];
                s += bflo(qr[d0][4]) * kb[0] + bflo(qr[d0][5]) * kb[1] + bflo(qr[d0][6]) * kb[2] + bflo(qr[d0][7]) * kb[3]; }
            s = pair_sum(s);
            if (s > b0) { b2 = b1; i2 = i1; b1 = b0; i1 = i0; b0 = s; i0 = n; }
            else if (s > b1) { b2 = b1; i2 = i1; b1 = s; i1 = n; }
            else if (s > b2) { b2 = s; i2 = n; }
        }
        unsigned mask = 1u << qb;
        if (b0 > -INFINITY) mask |= 1u << i0;
        if (b1 > -INFINITY) mask |= 1u << i1;
        if (b2 > -INFINITY) mask |= 1u << i2;
        const float craw = slope / MobaPol::SCALE;
        const int kt_first = part == 1 ? 2 * qb + 1 : 4 * qb + 3, kt_last = part == 0 ? 2 * qb + 2 : 0;
        MobaPol pol{PB, h, qb, t0w, t0w + r32, mask, craw, aug_split(craw), qkmax, kt_first, kt_last, -qkmax + craw * (float)(t0w + r32 - qb * 256)};
        f32x16 o[4] = {}; float m_reg = -1e30f, l_reg = 0.f;
        flash_pass<MobaPol>(pol, lds, qr, o, m_reg, l_reg);
        bool write_out = true;
        if (part >= 0) {
            unsigned char* sb = scratch + ((size_t)((h - 6) * 16 + (qb - 16)) * 2 + part) * (size_t)(65536 + 4096);
            u32x4* so = (u32x4*)sb + (wid * 8) * 64 + lane;
#pragma unroll
            for (int d0 = 0; d0 < 4; ++d0)
#pragma unroll
                for (int q4 = 0; q4 < 2; ++q4) { u32x4 w; w.x = cvtpk(o[d0][q4 * 8 + 0], o[d0][q4 * 8 + 1]); w.y = cvtpk(o[d0][q4 * 8 + 2], o[d0][q4 * 8 + 3]);
                    w.z = cvtpk(o[d0][q4 * 8 + 4], o[d0][q4 * 8 + 5]); w.w = cvtpk(o[d0][q4 * 8 + 6], o[d0][q4 * 8 + 7]); so[(d0 * 2 + q4) * 64] = w; }
            ((float2*)(sb + 65536))[wid * 64 + lane] = make_float2(m_reg, l_reg);
            asm volatile("s_waitcnt vmcnt(0)" ::: "memory");
            __syncthreads();
            if (tid == 0) {
                __builtin_amdgcn_fence(__ATOMIC_RELEASE, "agent");
                asm volatile("s_waitcnt vmcnt(0)" ::: "memory");
                const unsigned old = __hip_atomic_fetch_add(split + h * 32 + qb, 1u, __ATOMIC_RELAXED, __HIP_MEMORY_SCOPE_AGENT);
                __builtin_amdgcn_fence(__ATOMIC_ACQUIRE, "agent");
                asm volatile("s_waitcnt vmcnt(0)" ::: "memory");
                *slot = (int)old;
            }
            __syncthreads();
            write_out = (*slot != 0);
            if (write_out) {
                const unsigned char* pb = scratch + ((size_t)((h - 6) * 16 + (qb - 16)) * 2 + (1 - part)) * (size_t)(65536 + 4096);
                const float2 ml = ((const float2*)(pb + 65536))[wid * 64 + lane];
                constexpr float C = MobaPol::SCALE * LOG2E;
                const float mN = part == 0 ? m_reg : ml.x, mF = part == 0 ? ml.x : m_reg, lN = part == 0 ? l_reg : ml.y, lF = part == 0 ? ml.y : l_reg;
                const float M = fmaxf(mN, mF);
                const float fN = __builtin_amdgcn_exp2f((mN - M) * C), fF = __builtin_amdgcn_exp2f((mF - M) * C);
                l_reg = __fadd_rn(__fmul_rn(lN, fN), __fmul_rn(lF, fF));
                float FN[16], FF[16];
                row_factor(lds + PolLds<MobaPol>::WS0, fN, FN);
                row_factor(lds + PolLds<MobaPol>::WS0, fF, FF);
                const u32x4* po = (const u32x4*)pb + (wid * 8) * 64 + lane;
                const u32x4* pown = (const u32x4*)sb + (wid * 8) * 64 + lane;
#pragma unroll
                for (int d0 = 0; d0 < 4; ++d0)
#pragma unroll
                    for (int q4 = 0; q4 < 2; ++q4) { const u32x4 w = po[(d0 * 2 + q4) * 64]; const unsigned ww[4] = {w.x, w.y, w.z, w.w};
                        const u32x4 wo = pown[(d0 * 2 + q4) * 64]; const unsigned wwo[4] = {wo.x, wo.y, wo.z, wo.w};
#pragma unroll
                        for (int e2 = 0; e2 < 4; ++e2) { const int r = q4 * 8 + e2 * 2;
                            const float own0 = __uint_as_float(wwo[e2] << 16), own1 = __uint_as_float(wwo[e2] & 0xffff0000u);
                            const float oth0 = __uint_as_float(ww[e2] << 16), oth1 = __uint_as_float(ww[e2] & 0xffff0000u);
                            const float n0 = part == 0 ? own0 : oth0, f0 = part == 0 ? oth0 : own0, n1 = part == 0 ? own1 : oth1, f1 = part == 0 ? oth1 : own1;
                            o[d0][r] = __fadd_rn(__fmul_rn(n0, FN[r]), __fmul_rn(f0, FF[r]));
                            o[d0][r + 1] = __fadd_rn(__fmul_rn(n1, FN[r + 1]), __fmul_rn(f1, FF[r + 1])); } }
            }
        }
        if (write_out) {
            float rli[16];
            row_inv_l(lds + PolLds<MobaPol>::WS0, l_reg, rli);
#pragma unroll
            for (int r = 0; r < 16; ++r) { const int tok = t0w + crow(r, hi);
                const bf16_t* g = PB + (size_t)tok * 8192 + 6144 + h * 128; bf16_t* ao = AO + (size_t)tok * DM + h * 128;
#pragma unroll
                for (int d0 = 0; d0 < 4; ++d0) { const int col = d0 * 32 + r32; ao[col] = f2bf(o[d0][r] * rli[r] * silu_f(bf2f(g[col]))); } }
        }
        __syncthreads();
    }
}

__device__ __forceinline__ float pair_other(float v, int hi) { auto rr = __builtin_amdgcn_permlane32_swap(__float_as_uint(v), __float_as_uint(v), false, false); return __uint_as_float(hi ? rr[0] : rr[1]); }

__device__ __forceinline__ void sb_half(f32x16& p, int kpos0, bool diag, int qpos, int hi, float& run) {
    constexpr float SCALE = 0.08838834764831845f;
    f32x16 om;
#pragma unroll
    for (int r = 0; r < 16; ++r) { const float z = p[r] * SCALE; const float e = __builtin_amdgcn_exp2f(-fabsf(z) * LOG2E); const float rr = __builtin_amdgcn_rcpf(1.f + e), er = e * rr;
        p[r] = z >= 0.f ? rr : er; om[r] = z >= 0.f ? er : rr; }
    if (diag) {
#pragma unroll
        for (int r = 0; r < 16; ++r) if (kpos0 + crow(r, hi) >= qpos) { om[r] = 1.f; p[r] = 0.f; }
    }
#pragma unroll
    for (int k = 0; k < 4; ++k) { om[4 * k + 2] *= om[4 * k + 3]; om[4 * k + 1] *= om[4 * k + 2]; om[4 * k] *= om[4 * k + 1]; }
#pragma unroll
    for (int k = 3; k >= 0; --k) {
        const float tm = om[4 * k], to = pair_other(tm, hi);
        const float sk = hi == 0 ? run * to : run; run *= tm * to;
        p[4 * k + 3] *= sk; p[4 * k + 2] *= sk * om[4 * k + 3]; p[4 * k + 1] *= sk * om[4 * k + 2]; p[4 * k] *= sk * om[4 * k + 1];
    }
}
__device__ __forceinline__ void sb_attn_phase(unsigned char* lds, const bf16_t* PB, bf16_t* AO) {
    constexpr int SLOT = 32768, KBY = 16384;
    int tid = threadIdx.x; asm volatile("" : "+v"(tid));
    const int wid = tid >> 6, lane = tid & 63, r32 = lane & 31, hi = lane >> 5;
    const int bx = blockIdx.x;
    const int h = (bx & 7) * 2 + ((bx >> 3) >> 4), j = (bx >> 3) & 15;
    volatile LAS int* flags = (volatile LAS int*)(lds + 4 * SLOT);
    const int sr = tid >> 4, sc = tid & 15;
    const int vst0 = v_st(sr, sc * 8), vst1 = v_st(32 + sr, sc * 8);
    const int vbl = (int)(uintptr_t)lds + KBY + v_rd_base(lane);
    const bf16_t* kbase = PB + 2048 + h * 128 + sc * 8; const bf16_t* vbase = PB + 4096 + h * 128 + sc * 8;
    for (int uu = 0; uu < 2; ++uu) {
        const int qb = uu == 0 ? 31 - j : j;
        const int t0w = qb * 256 + wid * 32, qpos = t0w + r32;
        bf16x8 qr[8];
        load_q<128>(PB + (size_t)qpos * 8192 + h * 128, hi, qr);
        f32x16 o[4] = {}; float carry = 1.f; bool done = false;
        const int T = qb * 4, my_top = (t0w + 30) >> 6;
        u32x4 sk0, sk1, sv0, sv1, tk0, tk1, tv0, tv1;
#define SB_SLOAD(kt, K0, K1, V0, V1) do { const size_t kb_ = (size_t)(kt) * 64; K0 = *(const u32x4*)(kbase + (kb_ + sr) * 8192); K1 = *(const u32x4*)(kbase + (kb_ + 32 + sr) * 8192); \
        V0 = *(const u32x4*)(vbase + (kb_ + sr) * 8192); V1 = *(const u32x4*)(vbase + (kb_ + 32 + sr) * 8192); } while (0)
#define SB_SWRITE(kt, K0, K1, V0, V1) do { unsigned char* sl_ = lds + ((kt) & 3) * SLOT; *(u32x4*)(sl_ + kswz<128>(sr, sc * 16)) = K0; *(u32x4*)(sl_ + kswz<128>(32 + sr, sc * 16)) = K1; \
        *(u32x4*)(sl_ + KBY + vst0) = V0; *(u32x4*)(sl_ + KBY + vst1) = V1; } while (0)
        SB_SLOAD(T + 3, sk0, sk1, sv0, sv1); SB_SLOAD(T + 2, tk0, tk1, tv0, tv1);
        SB_SWRITE(T + 3, sk0, sk1, sv0, sv1); SB_SWRITE(T + 2, tk0, tk1, tv0, tv1);
        SB_SLOAD(T + 1, sk0, sk1, sv0, sv1); SB_SLOAD(T, tk0, tk1, tv0, tv1);
        SB_SWRITE(T + 1, sk0, sk1, sv0, sv1); SB_SWRITE(T, tk0, tk1, tv0, tv1);
        __syncthreads();
        for (int s = 0;; ++s) {
            const int tin = T - s - 1, kt = my_top - s;
            if (tin >= 0) SB_SLOAD(tin, sk0, sk1, sv0, sv1);
            if (!done && kt >= 0) {
                const unsigned char* Kc = lds + (kt & 3) * SLOT;
                const int kb = kt * 64;
                const bool diag = kb + 63 >= t0w;
                float run = carry;
                f32x16 p1 = {};
#pragma unroll
                for (int d0 = 0; d0 < 8; ++d0) p1 = __builtin_amdgcn_mfma_f32_32x32x16_bf16(*(const bf16x8*)(Kc + kswz<128>(32 + r32, d0 * 32 + hi * 16)), qr[d0], p1, 0, 0, 0);
                sb_half(p1, kb + 32, diag, qpos, hi, run);
                f32x16 p0 = {};
#pragma unroll
                for (int d0 = 0; d0 < 8; ++d0) p0 = __builtin_amdgcn_mfma_f32_32x32x16_bf16(*(const bf16x8*)(Kc + kswz<128>(r32, d0 * 32 + hi * 16)), qr[d0], p0, 0, 0, 0);
                sb_half(p0, kb, diag, qpos, hi, run);
                carry = run;
                bf16x8 pa0, pa1, pa2, pa3;
                pack_p(p0, p1, pa0, pa1, pa2, pa3);
                pv_d0(o, vbl + (kt & 3) * SLOT, pa0, pa1, pa2, pa3);
                done = __all(carry == 0.f);
            }
            if (lane == 0) flags[(s & 1) * 8 + wid] = (done || kt <= 0) ? 1 : 0;
            __syncthreads();
            int alld = 1;
#pragma unroll
            for (int w = 0; w < 8; ++w) alld &= flags[(s & 1) * 8 + w];
            if (alld) break;
            if (tin >= 0) SB_SWRITE(tin, sk0, sk1, sv0, sv1);
            __syncthreads();
        }
#undef SB_SLOAD
#undef SB_SWRITE
#pragma unroll
        for (int r = 0; r < 16; ++r) { const int tok = t0w + crow(r, hi);
            const bf16_t* g = PB + (size_t)tok * 8192 + 6144 + h * 128; bf16_t* ao = AO + (size_t)tok * DM + h * 128;
#pragma unroll
            for (int d0 = 0; d0 < 4; ++d0) { const int col = d0 * 32 + r32; ao[col] = f2bf(o[d0][r] * silu_f(bf2f(g[col]))); } }
        __syncthreads();
    }
}

using NsaLds = LdsMap<128, 2, 2>;
constexpr int NSA_IMP = NsaLds::TOTAL + 128;
constexpr int NSA_COMB = NSA_IMP;
constexpr int NSA_SELM = NSA_COMB + 8 * 32 * 64 * 4;
static_assert(NSA_SELM + 1024 <= 163840 - 16, "NSA LDS map");
struct NsaCmpPol {
    static constexpr int DK = 128; static constexpr float SCALE = 0.08838834764831845f; static constexpr bool AUG = false, STOP = true, SKEW = false; static constexpr int RING = 2;
    const bf16_t* KC; const bf16_t* VC; int kt_hi; int tmaxw; int qpos; float nslope; float qkmax;
    __device__ __forceinline__ const bf16_t* kptr(int key, int c) const { return KC + (size_t)key * 128 + c * 8; }
    __device__ __forceinline__ const bf16_t* vptr(int key, int c) const { return VC + (size_t)key * 128 + c * 8; }
    __device__ __forceinline__ int first_tile() const { return kt_hi; }
    __device__ __forceinline__ int next_tile(int kt) const { return kt - 1; }
    __device__ __forceinline__ bool wave_skip(int kt) const { return 16 * (64 * kt) + 31 > tmaxw; }
    __device__ __forceinline__ bool wave_done(int nk, float m) const { return __all((qkmax + nslope * (float)(qpos - (16 * (64 * nk + 63) + 31)) - m) * (SCALE * LOG2E) < -152.f); }
    __device__ __forceinline__ bool need_mask(int) const { return true; }
    __device__ __forceinline__ unsigned tile_state(int) const { return 0u; }
    __device__ __forceinline__ float score(float s, int n, unsigned) const { const int ce = 16 * n + 31; return ce <= qpos ? fmaf(nslope, (float)(qpos - ce), s) : -INFINITY; }
};
__device__ __forceinline__ unsigned pick_word(int b, unsigned w0, unsigned w1, unsigned w2, unsigned w3) { return b < 64 ? (b < 32 ? w0 : w1) : (b < 96 ? w2 : w3); }
struct NsaSelPol {
    static constexpr int DK = 128; static constexpr float SCALE = 0.08838834764831845f; static constexpr bool AUG = true, STOP = true, SKEW = false; static constexpr int RING = 2;
    const bf16_t* PB; int g; int tb; int qpos; float craw; AugC cc; float qkmax; const unsigned* mrow; unsigned u0, u1, u2, u3;
    __device__ __forceinline__ const bf16_t* kptr(int key, int c) const { return PB + (size_t)key * LD3 + 3072 + g * 128 + c * 8; }
    __device__ __forceinline__ const bf16_t* vptr(int key, int c) const { return PB + (size_t)key * LD3 + 3584 + g * 128 + c * 8; }
    __device__ __forceinline__ int first_tile() const { return tb; }
    __device__ __forceinline__ int next_tile(int kt) const { for (int b = kt - 1; b >= 0; --b) if ((pick_word(b, u0, u1, u2, u3) >> (b & 31)) & 1u) return b; return -1; }
    __device__ __forceinline__ unsigned tile_state(int kt) const { return (mrow[kt >> 5] >> (kt & 31)) & 1u; }
    __device__ __forceinline__ bool wave_skip(int kt) const { return !__any((int)tile_state(kt)); }
    __device__ __forceinline__ bf16x8 qaug(int kt, int hi) const { return aug_q(cc, !tile_state(kt), hi); }
    __device__ __forceinline__ float tile_bias(int kt) const { return craw * (float)((kt - tb) * 64); }
    __device__ __forceinline__ bool wave_done(int nk, float m) const { return __all((qkmax + craw * (float)((nk - tb) * 64 + 63) - m) * (SCALE * LOG2E) < -152.f); }
    __device__ __forceinline__ bool need_mask(int kt) const { return kt == tb; }
    __device__ __forceinline__ float score(float s, int kpos, unsigned) const { return kpos <= qpos ? s : -INFINITY; }
};
struct NsaWinPol {
    static constexpr int DK = 128; static constexpr float SCALE = 0.08838834764831845f; static constexpr bool AUG = true, STOP = true, SKEW = false; static constexpr int RING = 2;
    const bf16_t* PB; int g; int tb; int qpos; float craw; AugC cc; float qkmax;
    __device__ __forceinline__ const bf16_t* kptr(int key, int c) const { return PB + (size_t)key * LD3 + 4096 + g * 128 + c * 8; }
    __device__ __forceinline__ const bf16_t* vptr(int key, int c) const { return PB + (size_t)key * LD3 + 4608 + g * 128 + c * 8; }
    __device__ __forceinline__ int first_tile() const { return tb; }
    __device__ __forceinline__ int next_tile(int kt) const { return (kt > 0 && kt > tb - 8) ? kt - 1 : -1; }
    __device__ __forceinline__ bool wave_skip(int) const { return false; }
    __device__ __forceinline__ bf16x8 qaug(int, int hi) const { return aug_q(cc, false, hi); }
    __device__ __forceinline__ float tile_bias(int kt) const { return craw * (float)((kt - tb) * 64); }
    __device__ __forceinline__ bool wave_done(int nk, float m) const { return __all((qkmax + craw * (float)((nk - tb) * 64 + 63) - m) * (SCALE * LOG2E) < -152.f); }
    __device__ __forceinline__ bool need_mask(int kt) const { return kt == tb || kt == tb - 8; }
    __device__ __forceinline__ unsigned tile_state(int) const { return 0u; }
    __device__ __forceinline__ float score(float s, int kpos, unsigned) const { const int d = qpos - kpos; return (d >= 0 && d < 512) ? s : -INFINITY; }
};
__device__ __forceinline__ void nsa_importance(const NsaCmpPol& pol, int kt_lo, unsigned char* lds, const bf16x8 (&qr)[8], float m_reg, float l_reg, float* impw) {
    using L = NsaLds;
    constexpr float C = NsaCmpPol::SCALE * LOG2E;
    int tid = threadIdx.x; asm volatile("" : "+v"(tid));
    const int lane = tid & 63, r32 = lane & 31, hi = lane >> 5;
    unsigned char* Kl = lds + L::K0;
    const int sr = tid >> 4, sc = tid & 15;
    bf16x8 cf[4];
#pragma unroll
    for (int ks = 0; ks < 4; ++ks)
#pragma unroll
        for (int jj = 0; jj < 8; ++jj) { const int nl = 16 * ks + 8 * hi + jj; cf[ks][jj] = (4 * r32 - 1 <= nl && nl <= 4 * r32 + 3) ? (short)0x3F80 : (short)0; }
    const float il = l_reg > 0.f ? __builtin_amdgcn_rcpf(l_reg) : 0.f, mnC = -m_reg * C;
    u32x4 sk0, sk1;
#define NI_SLOAD(kt) do { const int kb_ = (kt) * 64; sk0 = *(const u32x4*)pol.kptr(kb_ + sr, sc); sk1 = *(const u32x4*)pol.kptr(kb_ + 32 + sr, sc); } while (0)
#define NI_SWRITE(b) do { *(u32x4*)(Kl + (b) * L::KB + kswz<128>(sr, sc * 16)) = sk0; *(u32x4*)(Kl + (b) * L::KB + kswz<128>(32 + sr, sc * 16)) = sk1; } while (0)
    NI_SLOAD(pol.kt_hi); NI_SWRITE(0); __syncthreads();
    for (int kt = pol.kt_hi, it = 0; kt >= kt_lo; --kt, ++it) {
        const int cur = it & 1;
        if (kt > kt_lo) NI_SLOAD(kt - 1);
        if (!pol.wave_skip(kt)) {
            const unsigned char* Kc = Kl + cur * L::KB;
            f32x16 p0 = {}, p1 = {};
#pragma unroll
            for (int d0 = 0; d0 < 8; ++d0) { const int cb = d0 * 32 + hi * 16;
                const bf16x8 b0 = *(const bf16x8*)(Kc + kswz<128>(r32, cb));
                const bf16x8 b1 = *(const bf16x8*)(Kc + kswz<128>(32 + r32, cb));
                p0 = __builtin_amdgcn_mfma_f32_32x32x16_bf16(b0, qr[d0], p0, 0, 0, 0);
                p1 = __builtin_amdgcn_mfma_f32_32x32x16_bf16(b1, qr[d0], p1, 0, 0, 0); }
            const int kb = kt * 64;
#pragma unroll
            for (int r = 0; r < 16; ++r) {
                p0[r] = __builtin_amdgcn_exp2f(fmaf(pol.score(p0[r], kb + crow(r, hi), 0u), C, mnC)) * il;
                p1[r] = __builtin_amdgcn_exp2f(fmaf(pol.score(p1[r], kb + 32 + crow(r, hi), 0u), C, mnC)) * il; }
            bf16x8 pa0, pa1, pa2, pa3;
            pack_p(p0, p1, pa0, pa1, pa2, pa3);
            f32x16 acc = {};
            acc = __builtin_amdgcn_mfma_f32_32x32x16_bf16(pa0, cf[0], acc, 0, 0, 0);
            acc = __builtin_amdgcn_mfma_f32_32x32x16_bf16(pa1, cf[1], acc, 0, 0, 0);
            acc = __builtin_amdgcn_mfma_f32_32x32x16_bf16(pa2, cf[2], acc, 0, 0, 0);
            acc = __builtin_amdgcn_mfma_f32_32x32x16_bf16(pa3, cf[3], acc, 0, 0, 0);
            if (r32 <= 16) {
#pragma unroll
                for (int k = 0; k < 4; ++k) { float* q = impw + (2 * k + hi) * 160 + 16 * kt + r32; *q += (acc[4 * k] + acc[4 * k + 1]) + (acc[4 * k + 2] + acc[4 * k + 3]); }
            }
            asm volatile("s_waitcnt lgkmcnt(0)" ::: "memory");
        }
        if (kt > kt_lo) NI_SWRITE(cur ^ 1);
        __syncthreads();
    }
#undef NI_SLOAD
#undef NI_SWRITE
}
__device__ __forceinline__ unsigned wave_or(unsigned v) { for (int o = 32; o > 0; o >>= 1) v |= (unsigned)__shfl_xor((int)v, o); return v; }
__device__ __forceinline__ void nsa_attn_phase(unsigned char* lds, const bf16_t* PB, const bf16_t* KCb, const bf16_t* VCb, const float* qn, const float* kn3, unsigned* ctr, bf16_t* AO) {
    using L = NsaLds;
    constexpr float SCALE = 0.08838834764831845f;
    const int tid = threadIdx.x, wid = tid >> 6, lane = tid & 63, r32 = lane & 31, hi = lane >> 5;
    float* impw = (float*)(lds + NSA_IMP) + wid * (8 * 160);
    unsigned* combw = (unsigned*)(lds + NSA_COMB) + wid * (32 * 64) + lane;
    unsigned* selm = (unsigned*)(lds + NSA_SELM);
    unsigned char* lws = lds + L::WS0;
    const float gqmax = max_abs128(qn, lane);
    const float qk_sel = 128.f * 1.02f * gqmax * max_abs128(kn3 + 128, lane), qk_win = 128.f * 1.02f * gqmax * max_abs128(kn3 + 256, lane), qk_cmp = 128.f * 1.02f * gqmax * max_abs128(kn3, lane);
    volatile LAS int* slot = (volatile LAS int*)(lds + L::TOTAL + 64);
    const int xq = (int)blockIdx.x & 7, qtype = (xq >> 1) & 1, idx4 = (xq & 1) | ((xq >> 2) << 1);
    for (;;) {
        if (tid == 0) *slot = (int)__hip_atomic_fetch_add(ctr + xq * 8, 1u, __ATOMIC_RELAXED, __HIP_MEMORY_SCOPE_AGENT);
        __syncthreads();
        const int ui = *slot;
        if (ui >= (qtype ? 60 : 68)) break;
        int g, k;
        if (!qtype) { if (ui < 32) { g = 3; k = ui; } else if (ui < 36) { g = 1; k = ui - 32; } else { g = 0; k = ui - 36; } }
        else { if (ui < 32) { g = 2; k = ui; } else { g = 1; k = ui - 28; } }
        const int tb = 4 * (31 - k) + idx4;
        const int T0w = tb * 64 + wid * 8;
        const int tokl = T0w + (r32 >> 2), hl = g * 4 + (r32 & 3), qpos = tokl;
        const float nslope = -alibi_slope(hl) / SCALE;
        const bf16_t* rowl = PB + (size_t)tokl * LD3;
        bf16x8 qr[8];
        load_q<128>(rowl + hl * 128, hi, qr);
        norm_q128(qr, qn, hi);
        NsaCmpPol cpol{KCb + (size_t)g * 512 * 128, VCb + (size_t)g * 512 * 128, tb >> 4, T0w + 7, qpos, nslope, qk_cmp};
        f32x16 o[4] = {}; float m_reg = -1e30f, l_reg = 0.f; int kt_cmp_lo = 0;
        flash_pass<NsaCmpPol>(cpol, lds, qr, o, m_reg, l_reg, &kt_cmp_lo);
        for (int i = lane; i < 8 * 160; i += 64) impw[i] = 0.f;
        asm volatile("s_waitcnt lgkmcnt(0)" ::: "memory");
        nsa_importance(cpol, kt_cmp_lo, lds, qr, m_reg, l_reg, impw);
        for (int ti = 0; ti < 8; ++ti) {
            unsigned w0 = 0u, w1 = 0u, w2 = 0u, w3 = 0u;
            if (tb < 16) { w0 = (tb == 31) ? 0xffffffffu : ((1u << (tb + 1)) - 1u); }
            else {
                const float* iv = impw + ti * 160;
                float v0 = (lane >= 1 && lane <= tb - 2) ? iv[lane] : -INFINITY;
                float v1 = (lane + 64 <= tb - 2) ? iv[lane + 64] : -INFINITY;
                unsigned long long s0 = 1ull, s1 = 0ull;
                if (tb < 64) s0 |= 1ull << tb; else s1 |= 1ull << (tb - 64);
                if (tb - 1 < 64) s0 |= 1ull << (tb - 1); else s1 |= 1ull << (tb - 1 - 64);
                for (int r = 0; r < 13; ++r) {
                    const float mx = wave_max(fmaxf(v0, v1));
                    const unsigned long long b0 = __ballot(v0 == mx), b1 = __ballot(v1 == mx);
                    if (b0) { const int idx = __ffsll((long long)b0) - 1; s0 |= 1ull << idx; if (lane == idx) v0 = -INFINITY; }
                    else    { const int idx = __ffsll((long long)b1) - 1; s1 |= 1ull << idx; if (lane == idx) v1 = -INFINITY; }
                }
                w0 = (unsigned)s0; w1 = (unsigned)(s0 >> 32); w2 = (unsigned)s1; w3 = (unsigned)(s1 >> 32);
            }
            if (lane == 0) { unsigned* q = selm + (wid * 8 + ti) * 4; q[0] = w0; q[1] = w1; q[2] = w2; q[3] = w3; }
        }
        __syncthreads();
        unsigned u0, u1, u2, u3;
        { const unsigned* q = selm + lane * 4; u0 = wave_or(q[0]); u1 = wave_or(q[1]); u2 = wave_or(q[2]); u3 = wave_or(q[3]);
          u0 = __builtin_amdgcn_readfirstlane(u0); u1 = __builtin_amdgcn_readfirstlane(u1); u2 = __builtin_amdgcn_readfirstlane(u2); u3 = __builtin_amdgcn_readfirstlane(u3); }
        float fr[16];
        row_factor(lws, l_reg > 0.f ? sigmoid_f(bf2f(rowl[5120 + hl * 3])) * __builtin_amdgcn_rcpf(l_reg) : 0.f, fr);
#pragma unroll
        for (int d0 = 0; d0 < 4; ++d0)
#pragma unroll
            for (int r = 0; r < 16; r += 2) combw[(d0 * 8 + (r >> 1)) * 64] = cvtpk(o[d0][r] * fr[r], o[d0][r + 1] * fr[r + 1]);
        {
            NsaSelPol spol{PB, g, tb, qpos, -nslope, aug_split(-nslope), qk_sel, selm + (wid * 8 + (r32 >> 2)) * 4, u0, u1, u2, u3};
#pragma unroll
            for (int d = 0; d < 4; ++d) o[d] = f32x16{};
            m_reg = -1e30f; l_reg = 0.f;
            flash_pass<NsaSelPol>(spol, lds, qr, o, m_reg, l_reg);
            row_factor(lws, l_reg > 0.f ? sigmoid_f(bf2f(rowl[5120 + hl * 3 + 1])) * __builtin_amdgcn_rcpf(l_reg) : 0.f, fr);
#pragma unroll
            for (int d0 = 0; d0 < 4; ++d0)
#pragma unroll
                for (int r = 0; r < 16; r += 2) { const unsigned c = combw[(d0 * 8 + (r >> 1)) * 64];
                    combw[(d0 * 8 + (r >> 1)) * 64] = cvtpk(__uint_as_float(c << 16) + o[d0][r] * fr[r], __uint_as_float(c & 0xffff0000u) + o[d0][r + 1] * fr[r + 1]); }
        }
        {
            NsaWinPol wpol{PB, g, tb, qpos, -nslope, aug_split(-nslope), qk_win};
#pragma unroll
            for (int d = 0; d < 4; ++d) o[d] = f32x16{};
            m_reg = -1e30f; l_reg = 0.f;
            flash_pass<NsaWinPol>(wpol, lds, qr, o, m_reg, l_reg);
            row_factor(lws, l_reg > 0.f ? sigmoid_f(bf2f(rowl[5120 + hl * 3 + 2])) * __builtin_amdgcn_rcpf(l_reg) : 0.f, fr);
#pragma unroll
            for (int r = 0; r < 16; ++r) { const int rw = crow(r, hi), tok = T0w + (rw >> 2), hh = g * 4 + (rw & 3);
                const bf16_t* gt = PB + (size_t)tok * LD3 + 5168 + hh * 128; bf16_t* ao = AO + (size_t)tok * DM + hh * 128;
#pragma unroll
                for (int d0 = 0; d0 < 4; ++d0) { const int col = d0 * 32 + r32; const unsigned c = combw[(d0 * 8 + (r >> 1)) * 64];
                    const float cv = (r & 1) ? __uint_as_float(c & 0xffff0000u) : __uint_as_float(c << 16);
                    ao[col] = f2bf((cv + o[d0][r] * fr[r]) * silu_f(bf2f(gt[col]))); } }
        }
        __syncthreads();
    }
}

typedef float f32x4v __attribute__((ext_vector_type(4)));
__device__ __forceinline__ void nsa_compress_phase(unsigned char* lds, const bf16_t* PB, const bf16_t* WCK, const bf16_t* WCV, const long long* c0, const float* gain, bf16_t* KC, bf16_t* VC) {
    const int tid = threadIdx.x, wid = tid >> 6, lane = tid & 63, row = lane & 15, kq = lane >> 4;
    float* part = (float*)lds;
    for (int u = blockIdx.x; u < 256; u += gridDim.x) {
        const int which = u & 1, g = (u >> 1) & 3, n0 = (u >> 3) * 16;
        const bf16_t* Wt = which ? WCV : WCK; const int col0 = (which ? 2560 : 2048) + g * 128;
        f32x4v acc[8];
#pragma unroll
        for (int ct = 0; ct < 8; ++ct) acc[ct] = f32x4v{0.f, 0.f, 0.f, 0.f};
        for (int kk = wid * 16; kk < wid * 16 + 16; ++kk) {
            const int l = kk >> 2, d = (kk & 3) * 32 + kq * 8;
            const bf16x8 a = *(const bf16x8*)(PB + (size_t)(16 * (n0 + row) + l) * LD3 + col0 + d);
#pragma unroll
            for (int ct = 0; ct < 8; ++ct) { const bf16x8 b = *(const bf16x8*)(Wt + (size_t)(ct * 16 + row) * 4096 + kk * 32 + kq * 8);
                acc[ct] = __builtin_amdgcn_mfma_f32_16x16x32_bf16(a, b, acc[ct], 0, 0, 0); }
        }
#pragma unroll
        for (int ct = 0; ct < 8; ++ct)
#pragma unroll
            for (int jj = 0; jj < 4; ++jj) part[(wid * 16 + kq * 4 + jj) * 128 + ct * 16 + row] = acc[ct][jj];
        __syncthreads();
        const int r = tid >> 5, c4 = (tid & 31) * 4;
        f32x4v s; { const long long* cp = c0 + which * 128 + c4; s[0] = (float)((double)cp[0] * (1.0 / 68719476736.0)); s[1] = (float)((double)cp[1] * (1.0 / 68719476736.0));
                    s[2] = (float)((double)cp[2] * (1.0 / 68719476736.0)); s[3] = (float)((double)cp[3] * (1.0 / 68719476736.0)); }
#pragma unroll
        for (int w = 0; w < 8; ++w) s += *(const f32x4v*)(part + (w * 16 + r) * 128 + c4);
        if (which == 0) {
            float ss = (s[0] * s[0] + s[1] * s[1]) + (s[2] * s[2] + s[3] * s[3]);
            for (int o = 16; o > 0; o >>= 1) ss += __shfl_xor(ss, o);
            const float rinv = rsqrtf(ss * (1.f / 128.f) + 1e-6f);
            const f32x4v gv = *(const f32x4v*)(gain + c4);
            s = s * rinv * gv;
        }
        const int n = n0 + r;
        if (n == 511) s = f32x4v{0.f, 0.f, 0.f, 0.f};
        uint2 wv; wv.x = cvtpk(s[0], s[1]); wv.y = cvtpk(s[2], s[3]);
        *(uint2*)((which ? VC : KC) + ((size_t)g * 512 + n) * 128 + c4) = wv;
        __syncthreads();
    }
}
__device__ __forceinline__ void nsa_c0_phase(const float* pos, const float* wk, const float* wv, long long* c0) {
    const int tid = threadIdx.x;
    if (tid >= 256) return;
    const int which = tid >> 7, c = tid & 127;
    const float* W = which ? wv : wk;
    float s = 0.f;
    for (int k = blockIdx.x * 16; k < blockIdx.x * 16 + 16; ++k) s += pos[k] * W[(size_t)k * 128 + c];
    atomicAdd((unsigned long long*)(c0 + which * 128 + c), (unsigned long long)(long long)llrint((double)s * 68719476736.0));
}

}


namespace tp {
__device__ __forceinline__ unsigned cvtpk(float lo, float hi) { unsigned r; asm volatile("v_cvt_pk_bf16_f32 %0, %1, %2" : "=v"(r) : "v"(lo), "v"(hi)); return r; }
__device__ __forceinline__ void unpack8(const u32x4 w, float (&f)[8]) {
    f[0] = __uint_as_float(w.x << 16); f[1] = __uint_as_float(w.x & 0xffff0000u); f[2] = __uint_as_float(w.y << 16); f[3] = __uint_as_float(w.y & 0xffff0000u);
    f[4] = __uint_as_float(w.z << 16); f[5] = __uint_as_float(w.z & 0xffff0000u); f[6] = __uint_as_float(w.w << 16); f[7] = __uint_as_float(w.w & 0xffff0000u);
}
__device__ __forceinline__ u32x4 pack8(const float (&f)[8]) { u32x4 w; w.x = cvtpk(f[0], f[1]); w.y = cvtpk(f[2], f[3]); w.z = cvtpk(f[4], f[5]); w.w = cvtpk(f[6], f[7]); return w; }
template <int GROUP> __device__ __forceinline__ float group_sum(float v) {
#pragma unroll
    for (int o = GROUP / 2; o > 0; o >>= 1) v += __shfl_xor(v, o);
    return v;
}
template <int GROUP> __device__ __forceinline__ void norm8(const bf16_t* p, const float* g, float (&f)[8]) {
    unpack8(*(const u32x4*)p, f);
    float ss = 0.f;
#pragma unroll
    for (int e = 0; e < 8; ++e) ss += f[e] * f[e];
    ss = group_sum<GROUP>(ss);
    const float r = rsqrtf(ss * (1.f / (8.f * GROUP)) + 1e-6f);
    const f32x4 g0 = *(const f32x4*)g, g1 = *(const f32x4*)(g + 4);
    f[0] *= r * g0[0]; f[1] *= r * g0[1]; f[2] *= r * g0[2]; f[3] *= r * g0[3]; f[4] *= r * g1[0]; f[5] *= r * g1[1]; f[6] *= r * g1[2]; f[7] *= r * g1[3];
}
__device__ __forceinline__ void rmsnorm_phase(const float* __restrict__ x, const float* __restrict__ g, bf16_t* __restrict__ out) {
    const int wid = threadIdx.x >> 6, lane = threadIdx.x & 63;
    for (int row = blockIdx.x * 8 + wid; row < SEQ; row += gridDim.x * 8) {
        const f32x4* xr = (const f32x4*)(x + (size_t)row * DM);
        f32x4 v[8]; float ss = 0.f;
#pragma unroll
        for (int i = 0; i < 8; ++i) { v[i] = xr[i * 64 + lane]; ss += (v[i][0] * v[i][0] + v[i][1] * v[i][1]) + (v[i][2] * v[i][2] + v[i][3] * v[i][3]); }
        ss = wave_sum(ss);
        const float r = rsqrtf(ss * (1.f / DM) + 1e-6f);
        uint2* o = (uint2*)(out + (size_t)row * DM);
#pragma unroll
        for (int i = 0; i < 8; ++i) { const f32x4 gv = ((const f32x4*)g)[i * 64 + lane]; uint2 w; w.x = cvtpk(v[i][0] * r * gv[0], v[i][1] * r * gv[1]); w.y = cvtpk(v[i][2] * r * gv[2], v[i][3] * r * gv[3]); o[i * 64 + lane] = w; }
    }
}
struct ConvJob { const float* W; bf16_t* Wt; int K, N; const float* g; };
__device__ __forceinline__ int conv_tiles(const ConvJob& j) { return (j.K / 128) * ((j.N + 127) / 128); }
struct ConvRegs { f32x4 a[4], b[4]; };
__device__ __forceinline__ void conv_load(const ConvJob& j, int tile, ConvRegs& r) {
    const int tid = threadIdx.x, K = j.K, N = j.N, nkt = K / 128;
    const int n4 = (tid & 31) * 4, kp = tid >> 5;
    const int k0 = (tile % nkt) * 128, n0 = (tile / nkt) * 128;
#pragma unroll
    for (int s = 0; s < 4; ++s) {
        const int kpair = kp + 16 * s;
        r.a[s] = f32x4{0.f, 0.f, 0.f, 0.f}; r.b[s] = f32x4{0.f, 0.f, 0.f, 0.f};
        if (n0 + n4 < N) { const float* wp = j.W + (size_t)(k0 + 2 * kpair) * N + n0 + n4; r.a[s] = *(const f32x4*)wp; r.b[s] = *(const f32x4*)(wp + N);
            if (j.g) { const float ga = j.g[k0 + 2 * kpair], gb = j.g[k0 + 2 * kpair + 1]; r.a[s] *= ga; r.b[s] *= gb; } }
    }
}
__device__ __forceinline__ void conv_finish(const ConvJob& j, int tile, const ConvRegs& r, unsigned char* lds) {
    const int tid = threadIdx.x, K = j.K, N = j.N, nkt = K / 128;
    LAS unsigned* T = (LAS unsigned*)lds;
    const int n4 = (tid & 31) * 4, kp = tid >> 5;
    const int sn = tid >> 2, skc = (tid & 3) * 16;
    const int k0 = (tile % nkt) * 128, n0 = (tile / nkt) * 128;
#pragma unroll
    for (int s = 0; s < 4; ++s) { const int kpair = kp + 16 * s;
#pragma unroll
        for (int jj = 0; jj < 4; ++jj) T[(n4 + jj) * 65 + kpair] = cvtpk(r.a[s][jj], r.b[s][jj]); }
    __syncthreads();
    if (n0 + sn < N) {
        bf16_t* dst = j.Wt + (size_t)(n0 + sn) * K + k0 + skc * 2;
#pragma unroll
        for (int q = 0; q < 4; ++q) { u32x4 v; v.x = T[sn * 65 + skc + 4 * q]; v.y = T[sn * 65 + skc + 4 * q + 1]; v.z = T[sn * 65 + skc + 4 * q + 2]; v.w = T[sn * 65 + skc + 4 * q + 3];
            *(u32x4*)(dst + 8 * q) = v; }
    }
    __syncthreads();
}
__device__ __forceinline__ void conv_wT(const float* __restrict__ W, bf16_t* __restrict__ Wt, int K, int N, unsigned char* lds, const float* g = nullptr) {
    const ConvJob j{W, Wt, K, N, g};
    const int nt = conv_tiles(j);
    int tile = blockIdx.x;
    ConvRegs ra, rb;
    if (tile < nt) conv_load(j, tile, ra);
    while (tile < nt) {
        const int nx = tile + gridDim.x;
        if (nx < nt) conv_load(j, nx, rb);
        conv_finish(j, tile, ra, lds);
        ra = rb; tile = nx;
    }
}
__device__ __forceinline__ void conv_static3(const ConvJob& j0, const ConvJob& j1, const ConvJob& j2, int first, int stride, unsigned char* lds) {
    const int n0 = conv_tiles(j0), n1 = n0 + conv_tiles(j1), n2 = n1 + conv_tiles(j2);
#define CS_JOB(t) ((t) < n0 ? j0 : (t) < n1 ? j1 : j2)
#define CS_LOCAL(t) ((t) < n0 ? (t) : (t) < n1 ? (t) - n0 : (t) - n1)
    ConvRegs ra, rb;
    int t = first;
    if (t < n2) conv_load(CS_JOB(t), CS_LOCAL(t), ra);
    while (t < n2) {
        const int tn = t + stride;
        if (tn < n2) conv_load(CS_JOB(tn), CS_LOCAL(tn), rb);
        conv_finish(CS_JOB(t), CS_LOCAL(t), ra, lds);
        ra = rb; t = tn;
    }
#undef CS_JOB
#undef CS_LOCAL
}
__device__ __forceinline__ void rope_slice(float* tab, int e0, int n) {
    for (int idx = e0 + (int)threadIdx.x; idx < e0 + n; idx += 512) {
        const int pos = idx >> 5, i = idx & 31;
        const float inv = powf(10000.f, -(float)(2 * i) / 64.f);
        const double a = (double)((float)pos * inv);
        tab[idx * 2 + 0] = (float)cos(a); tab[idx * 2 + 1] = (float)sin(a);
    }
}
__device__ __forceinline__ void conv_drain(const ConvJob& j0, const ConvJob& j1, const ConvJob& j2, const ConvJob& j3, unsigned* ctr, unsigned* arr, unsigned char* lds) {
    const int n0 = conv_tiles(j0), n1 = n0 + conv_tiles(j1), n2 = n1 + conv_tiles(j2), n3 = n2 + conv_tiles(j3);
    volatile LAS int* slot = (volatile LAS int*)(lds + 34816);
    __syncthreads();
    if (arr && threadIdx.x == 0) (void)__hip_atomic_fetch_add(arr, 1u, __ATOMIC_RELAXED, __HIP_MEMORY_SCOPE_AGENT);
#define CD_PULL() do { if (threadIdx.x == 0) { \
        if (arr && __hip_atomic_load(arr, __ATOMIC_RELAXED, __HIP_MEMORY_SCOPE_AGENT) >= gridDim.x) *slot = 0x7fffffff; \
        else *slot = (int)__hip_atomic_fetch_add(ctr, 1u, __ATOMIC_RELAXED, __HIP_MEMORY_SCOPE_AGENT); } } while (0)
#define CD_JOB(t) ((t) < n0 ? j0 : (t) < n1 ? j1 : (t) < n2 ? j2 : j3)
#define CD_LOCAL(t) ((t) < n0 ? (t) : (t) < n1 ? (t) - n0 : (t) < n2 ? (t) - n1 : (t) - n2)
    ConvRegs ra, rb;
    CD_PULL(); __syncthreads();
    int t = *slot;
    if (t < n3) conv_load(CD_JOB(t), CD_LOCAL(t), ra);
    while (t < n3) {
        __syncthreads();
        CD_PULL(); __syncthreads();
        const int tn = *slot;
        if (tn < n3) conv_load(CD_JOB(tn), CD_LOCAL(tn), rb);
        conv_finish(CD_JOB(t), CD_LOCAL(t), ra, lds);
        ra = rb; t = tn;
    }
#undef CD_PULL
#undef CD_JOB
#undef CD_LOCAL
    __syncthreads();
}
__device__ __forceinline__ void moba_prep_phase(bf16_t* __restrict__ PB, const float* __restrict__ qn, const float* __restrict__ kn, float* __restrict__ KPART, unsigned char* lds) {
    const int tid = threadIdx.x, wid = tid >> 6, lane = tid & 63;
    float ks[4][8];
#pragma unroll
    for (int i = 0; i < 4; ++i)
#pragma unroll
        for (int e = 0; e < 8; ++e) ks[i][e] = 0.f;
    for (int t = 0; t < 4; ++t) {
        const int tok = blockIdx.x * 32 + wid * 4 + t;
        bf16_t* row = PB + (size_t)tok * 8192;
        float f[8];
#pragma unroll
        for (int i = 0; i < 4; ++i) { bf16_t* p = row + 2048 + (i * 64 + lane) * 8; norm8<16>(p, kn + (lane & 15) * 8, f); const u32x4 w = pack8(f); *(u32x4*)p = w;
            float fr[8]; unpack8(w, fr);
#pragma unroll
            for (int e = 0; e < 8; ++e) ks[i][e] += fr[e]; }
    }
    float* red = (float*)lds;
#pragma unroll
    for (int i = 0; i < 4; ++i) { float* d = red + wid * 2048 + (i * 64 + lane) * 8; *(f32x4*)d = f32x4{ks[i][0], ks[i][1], ks[i][2], ks[i][3]}; *(f32x4*)(d + 4) = f32x4{ks[i][4], ks[i][5], ks[i][6], ks[i][7]}; }
    __syncthreads();
    f32x4 s = *(const f32x4*)(red + tid * 4);
#pragma unroll
    for (int w = 1; w < 8; ++w) s += *(const f32x4*)(red + w * 2048 + tid * 4);
    *(f32x4*)(KPART + (size_t)blockIdx.x * 2048 + tid * 4) = s;
    __syncthreads();
}
__device__ __forceinline__ void nsa_prep_phase(bf16_t* __restrict__ PB, const float* __restrict__ qn, const float* __restrict__ kn3) {
    const int wid = threadIdx.x >> 6, lane = threadIdx.x & 63;
    for (int tok = blockIdx.x * 8 + wid; tok < SEQ; tok += gridDim.x * 8) {
        bf16_t* row = PB + (size_t)tok * LD3;
        float f[8];
        { bf16_t* p = row + 3072 + lane * 8; norm8<16>(p, kn3 + 128 + (lane & 15) * 8, f); *(u32x4*)p = pack8(f); }
        { bf16_t* p = row + 4096 + lane * 8; norm8<16>(p, kn3 + 256 + (lane & 15) * 8, f); *(u32x4*)p = pack8(f); }
    }
}
}

namespace fa {
__device__ __forceinline__ void mla_kvup_phase(unsigned char* lds, const bf16_t* __restrict__ KVL, const bf16_t* __restrict__ Wt, const pg8::u64acc* __restrict__ kvss,
                                               const float* __restrict__ knorm, const float* __restrict__ rope, const bf16_t* __restrict__ PB,
                                               bf16_t* __restrict__ KVU, bf16_t* __restrict__ KR) {
    const int tid = threadIdx.x, wid = tid >> 6, lane = tid & 63, r32 = lane & 31, hi = lane >> 5;
    const int h = (int)blockIdx.x & 15, pbase = (int)blockIdx.x >> 4;
    {
        for (int t = 0; t < 4; ++t) { const int tok = (int)blockIdx.x * 32 + wid * 4 + t; const int l8 = lane & 7;
            float f[8]; tp::norm8<8>(PB + (size_t)tok * 3072 + 768 + l8 * 8, knorm + 128 + l8 * 8, f);
            const float* cs = rope + ((size_t)tok * 32 + (l8 & 3) * 8) * 2;
            float o[8];
#pragma unroll
            for (int e = 0; e < 8; ++e) { const float other = __shfl_xor(f[e], 4); const float c = cs[2 * e], s = cs[2 * e + 1]; o[e] = (l8 < 4) ? (f[e] * c - other * s) : (other * s + f[e] * c); }
            if (lane < 8) *(u32x4*)(KR + (size_t)tok * 64 + lane * 8) = tp::pack8(o); }
    }
#pragma unroll 4
    for (int i = 0; i < 16; ++i) { const int idx = tid + 512 * i, row = idx >> 5, c = idx & 31;
        const u32x4 v = *(const u32x4*)(Wt + ((size_t)(h * 256 + row)) * 256 + c * 8);
        *(LAS u32x4*)(lds + row * 512 + ((c ^ (row & 15)) << 4)) = v; }
    __syncthreads();
    const int sw = r32 & 15;
    for (int u = 0; u < 2; ++u) {
        const int tok = (pbase + 16 * u) * 256 + wid * 32 + r32;
        const float st = rsqrtf(pg8::acc_get_fx(kvss + tok) * (1.f / 256.f) + 1e-6f);
        bf16x8 xf[16];
#pragma unroll
        for (int ks = 0; ks < 16; ++ks) xf[ks] = *(const bf16x8*)(KVL + (size_t)tok * 256 + ks * 16 + hi * 8);
        bf16_t* orow = KVU + (size_t)tok * 4096 + h * 256;
        f32x16 ak[4];
#pragma unroll
        for (int blk = 0; blk < 4; ++blk) { ak[blk] = f32x16{};
#pragma unroll
            for (int ks = 0; ks < 16; ++ks) { const bf16x8 a = *(const LAS bf16x8*)(lds + (blk * 32 + r32) * 512 + (((ks * 2 + hi) ^ sw) << 4));
                ak[blk] = __builtin_amdgcn_mfma_f32_32x32x16_bf16(a, xf[ks], ak[blk], 0, 0, 0); } }
        float ss = 0.f;
#pragma unroll
        for (int blk = 0; blk < 4; ++blk)
#pragma unroll
            for (int r = 0; r < 16; ++r) { ak[blk][r] *= st; ss += ak[blk][r] * ak[blk][r]; }
        ss = pair_sum(ss);
        const float rk = rsqrtf(ss * (1.f / 128.f) + 1e-6f);
#pragma unroll
        for (int blk = 0; blk < 4; ++blk)
#pragma unroll
            for (int g4 = 0; g4 < 4; ++g4) { const int c0 = blk * 32 + 8 * g4 + 4 * hi; const f32x4 gn = *(const f32x4*)(knorm + c0);
                uint2 w; w.x = cvtpk(ak[blk][4 * g4] * rk * gn[0], ak[blk][4 * g4 + 1] * rk * gn[1]); w.y = cvtpk(ak[blk][4 * g4 + 2] * rk * gn[2], ak[blk][4 * g4 + 3] * rk * gn[3]);
                *(uint2*)(orow + c0) = w; }
#pragma unroll
        for (int blk = 4; blk < 8; ++blk) { f32x16 av = {};
#pragma unroll
            for (int ks = 0; ks < 16; ++ks) { const bf16x8 a = *(const LAS bf16x8*)(lds + (blk * 32 + r32) * 512 + (((ks * 2 + hi) ^ sw) << 4));
                av = __builtin_amdgcn_mfma_f32_32x32x16_bf16(a, xf[ks], av, 0, 0, 0); }
#pragma unroll
            for (int g4 = 0; g4 < 4; ++g4) { const int c0 = blk * 32 + 8 * g4 + 4 * hi;
                uint2 w; w.x = cvtpk(av[4 * g4] * st, av[4 * g4 + 1] * st); w.y = cvtpk(av[4 * g4 + 2] * st, av[4 * g4 + 3] * st);
                *(uint2*)(orow + c0) = w; } }
    }
    __syncthreads();
}
}

constexpr int NTHREADS = 512;
constexpr int LDS_BYTES = 163840;
constexpr int LDS_BARW = LDS_BYTES - 16;
constexpr int NPHASES = 24;
struct Args { const float* in[26]; float* out; unsigned char* ws; int ph_lo, ph_hi; };

#define VGRID(T, NBX, NBY, CALL) do { constexpr int NV_ = NTHREADS / (T); const int vsub_ = (int)threadIdx.x / (T); const int tid = (int)threadIdx.x % (T); \
    const long nblk_ = (long)(NBX) * (NBY); const long per_ = (long)gridDim.x * NV_; \
    for (long base_ = 0; base_ < nblk_; base_ += per_) { long vb_ = base_ + (long)blockIdx.x * NV_ + vsub_; const bool active = vb_ < nblk_; if (!active) vb_ = nblk_ - 1; \
        const int bx = (int)(vb_ % (NBX)), by = (int)(vb_ / (NBX)); unsigned char* sm = lds + vsub_ * 32768; (void)bx; (void)by; (void)sm; (void)active; \
        CALL; __syncthreads(); } } while (0)

__global__ void __launch_bounds__(NTHREADS, 2) fwd(Args a) {
    extern __shared__ __attribute__((aligned(1024))) unsigned char lds[];
    if (threadIdx.x == 0) *(uint4*)(lds + LDS_BARW) = make_uint4(0u, 0u, 0u, 0u);
    __syncthreads();
    unsigned char* ws = a.ws;
    XcdBarrier bar = xcd_barrier_post((unsigned*)(ws + WS_BAR), (volatile LAS unsigned*)(lds + LDS_BARW));
    const float* x = a.in[0];
    const float* norm_a = a.in[1];  const float* w_in_a = a.in[2];  const float* q_lat_norm = a.in[3];
    const float* w_q_up = a.in[4];  const float* kv_lat_norm = a.in[5]; const float* w_kv_up = a.in[6];
    const float* q_norm_a = a.in[7]; const float* k_norm_a = a.in[8]; const float* w_out_a = a.in[9];
    const float* norm_b = a.in[10]; const float* w_in_b = a.in[11]; const float* q_norm_b = a.in[12];
    const float* k_norm_b = a.in[13]; const float* w_out_b = a.in[14];
    const float* norm_c = a.in[15]; const float* w_in_c = a.in[16]; const float* w_out_c = a.in[17];
    const float* norm_d = a.in[18]; const float* w_in_d = a.in[19]; const float* q_norm_d = a.in[20];
    const float* k_norm_d = a.in[21]; const float* w_cmp_k = a.in[22]; const float* w_cmp_v = a.in[23];
    const float* cmp_pos = a.in[24]; const float* w_out_d = a.in[25];
    float* out = a.out;
    float* rope = (float*)(ws + WS_ROPE);
    bf16_t* H = (bf16_t*)(ws + WS_H); bf16_t* AO = (bf16_t*)(ws + WS_AO);
    bf16_t* QL = (bf16_t*)(ws + WS_QL); bf16_t* KVL = (bf16_t*)(ws + WS_KVL); bf16_t* KR = (bf16_t*)(ws + WS_KR);
    float* KMEAN = (float*)(ws + WS_KMEAN); bf16_t* KCMP = (bf16_t*)(ws + WS_KCMP); bf16_t* VCMP = (bf16_t*)(ws + WS_VCMP);
    bf16_t* PB = (bf16_t*)(ws + WS_ARENA + AR_PB); bf16_t* QU = (bf16_t*)(ws + WS_ARENA + AR_QU); bf16_t* KVU = (bf16_t*)(ws + WS_ARENA + AR_KVU);
    long long* C0 = (long long*)(ws + WS_C0); pg8::u64acc* RSS = (pg8::u64acc*)(ws + WS_RSS); pg8::u64acc* LSS = (pg8::u64acc*)(ws + WS_LSS);
    unsigned char* wr0 = ws + WS_W; unsigned char* wr1 = ws + WS_W + WREG;
    bf16_t* WIN0 = (bf16_t*)(wr0 + WB_IN); bf16_t* WOUT0 = (bf16_t*)(wr0 + WB_OUT); bf16_t* WQUP = (bf16_t*)(wr0 + WB_QUP); bf16_t* WKVUP = (bf16_t*)(wr0 + WB_KVUP);
    bf16_t* WIN1 = (bf16_t*)(wr1 + WB_IN); bf16_t* WOUT1 = (bf16_t*)(wr1 + WB_OUT); bf16_t* WCK = (bf16_t*)(wr1 + WB_CK); bf16_t* WCV = (bf16_t*)(wr1 + WB_CV);
    unsigned* cq = (unsigned*)(ws + WS_BAR) + CQ_WORD0;
    const tp::ConvJob jnone{nullptr, nullptr, 128, 0, nullptr};
    const tp::ConvJob jl1a{w_in_b, WIN1, DM, 8192, norm_b}, jl1b{w_out_b, WOUT1, DM, DM, nullptr};
    const tp::ConvJob jl2a{w_in_c, WIN0, DM, 8192, norm_c}, jl2b{w_out_c, WOUT0, DM, DM, nullptr};
    const tp::ConvJob jl3a{w_in_d, WIN1, DM, 7216, norm_d}, jl3b{w_out_d, WOUT1, DM, DM, nullptr}, jl3c{w_cmp_k, WCK, 4096, 128, nullptr}, jl3d{w_cmp_v, WCV, 4096, 128, nullptr};
    unsigned* arrw = (unsigned*)(ws + WS_BAR) + 3776;
#define DRAIN1(ph) tp::conv_drain(jl1a, jl1b, jnone, jnone, cq, (ph) >= 0 ? arrw + (ph) : nullptr, lds)
#define DRAIN2(ph) tp::conv_drain(jl2a, jl2b, jnone, jnone, cq + 64, (ph) >= 0 ? arrw + (ph) : nullptr, lds)
#define DRAIN3(ph) tp::conv_drain(jl3a, jl3b, jl3c, jl3d, cq + 128, (ph) >= 0 ? arrw + (ph) : nullptr, lds)
    PG8_LAS unsigned char* glds = (PG8_LAS unsigned char*)lds;
#define GEMM_BF16(Aop, Bop, Nn, Kk, Oo, ldo) do { pg8::Gemm g_{(const pg8::bf16_t*)(Aop), (const pg8::bf16_t*)(Bop), SEQ, (Nn), (Kk)}; pg8::StaticOrder S_; S_.init(SEQ, (Nn), (int)gridDim.x, (int)blockIdx.x); \
        pg8::EpiBf16<0> E_{(pg8::bf16_t*)(Oo), (ldo), nullptr, 0, 0}; pg8::gemm_phase<pg8::EpiBf16<0>, pg8::StaticOrder>(glds, g_, S_, E_, nullptr); } while (0)
#define GEMM_BF16S(Aop, Bop, Nn, Oo, ldo, Rss) GEMM_BF16SK(Aop, Bop, Nn, DM, Oo, ldo, Rss)
#define GEMM_BF16SK(Aop, Bop, Nn, Kk, Oo, ldo, Rss) do { pg8::Gemm g_{(const pg8::bf16_t*)(Aop), (const pg8::bf16_t*)(Bop), SEQ, (Nn), (Kk)}; pg8::StaticOrder S_; S_.init(SEQ, (Nn), (int)gridDim.x, (int)blockIdx.x); \
        pg8::EpiBf16S E_{(pg8::bf16_t*)(Oo), (ldo), (Rss), 1.f / (Kk)}; pg8::gemm_phase<pg8::EpiBf16S, pg8::StaticOrder>(glds, g_, S_, E_, nullptr); } while (0)
#define GEMM_MLAIN() do { pg8::Gemm g_{(const pg8::bf16_t*)H, (const pg8::bf16_t*)WIN0, SEQ, 3072, DM}; pg8::StaticOrder S_; S_.init(SEQ, 3072, (int)gridDim.x, (int)blockIdx.x); \
        pg8::EpiMlaIn E_{(pg8::bf16_t*)PB, 3072, (pg8::bf16_t*)QL, (pg8::bf16_t*)KVL, LSS, LSS + SEQ}; pg8::gemm_phase<pg8::EpiMlaIn, pg8::StaticOrder>(glds, g_, S_, E_, nullptr); } while (0)
#define GEMM_RESX(Aop, Bop, Rr, Rss) do { pg8::Gemm g_{(const pg8::bf16_t*)(Aop), (const pg8::bf16_t*)(Bop), SEQ, DM, DM}; pg8::StaticOrder S_; S_.init(SEQ, DM, (int)gridDim.x, (int)blockIdx.x); \
        pg8::EpiResF32X E_{(Rr), out, (pg8::bf16_t*)H, (Rss), DM}; pg8::gemm_phase<pg8::EpiResF32X, pg8::StaticOrder>(glds, g_, S_, E_, nullptr); } while (0)
#define GEMM_RES(Aop, Bop, Rr) do { pg8::Gemm g_{(const pg8::bf16_t*)(Aop), (const pg8::bf16_t*)(Bop), SEQ, DM, DM}; pg8::StaticOrder S_; S_.init(SEQ, DM, (int)gridDim.x, (int)blockIdx.x); \
        pg8::EpiResF32 E_{(Rr), out, DM}; pg8::gemm_phase<pg8::EpiResF32, pg8::StaticOrder>(glds, g_, S_, E_, nullptr); } while (0)
    const int lo = a.ph_lo, hi = a.ph_hi;
#define IN(k) (lo <= (k) && (k) < hi)
#ifndef PROBE_MASK
#define PROBE_MASK 0u
#endif
#if PROBE_MASK
    unsigned long long tph_ = wall_clock64();
#define SEAM(k) do { if ((PROBE_MASK >> (k)) & 1u) { const unsigned long long t1_ = wall_clock64(); while (wall_clock64() < t1_ + (t1_ - tph_)) __builtin_amdgcn_s_sleep(8); } \
        if (IN(k) && IN((k) + 1)) xcd_barrier(bar); tph_ = wall_clock64(); } while (0)
#else
#define SEAM(k) do { if (IN(k) && IN((k) + 1)) xcd_barrier(bar); } while (0)
#endif

    if (IN(0)) { tp::rmsnorm_phase(x, norm_a, H); tp::conv_wT(w_in_a, WIN0, DM, 2880, lds); } SEAM(0);
    if (IN(1)) { GEMM_MLAIN();
                 if (blockIdx.x >= 128) {
                     tp::rope_slice(rope, ((int)blockIdx.x - 128) * 2048, 2048);
                     const tp::ConvJob ja{w_q_up, WQUP, 512, 3072, q_lat_norm}, jb{w_kv_up, WKVUP, 256, 4096, kv_lat_norm}, jc{w_out_a, WOUT0, DM, DM, nullptr};
                     tp::conv_static3(ja, jb, jc, (int)blockIdx.x - 128, 128, lds); }
                 DRAIN1(1); } SEAM(1);
    if (IN(3)) { GEMM_BF16SK(QL, WQUP, 3072, 512, QU, 3072, LSS);
                 fa::mla_kvup_phase(lds, KVL, WKVUP, LSS + SEQ, k_norm_a, rope, PB, KVU, KR); DRAIN1(3); } SEAM(3);
    if (IN(5)) { fa::mla_attn_phase(lds, QU, KVU, KR, PB, q_norm_a, rope, AO); DRAIN1(5); } SEAM(5);
    if (IN(6)) { GEMM_RESX(AO, WOUT0, x, RSS); DRAIN1(-1); } SEAM(6);
    if (IN(8)) { GEMM_BF16S(H, WIN1, 8192, PB, 8192, RSS); DRAIN2(8); } SEAM(8);
    if (IN(9)) { tp::moba_prep_phase(PB, q_norm_b, k_norm_b, KMEAN, lds); fa::moba_order_phase((int*)QL); DRAIN2(9); } SEAM(9);
    if (IN(11)) { fa::moba_attn_phase(lds, PB, KMEAN, q_norm_b, k_norm_b, (unsigned*)(ws + WS_BAR) + 3840, (unsigned*)(ws + WS_SPLIT), ws + WS_ARENA + (size_t)SEQ * 8192 * 2, (const int*)QL, AO); DRAIN2(11); } SEAM(11);
    if (IN(12)) { GEMM_RESX(AO, WOUT1, (const float*)out, RSS + SEQ); DRAIN2(-1); } SEAM(12);
    if (IN(14)) { GEMM_BF16S(H, WIN0, 8192, PB, 8192, RSS + SEQ); fa::nsa_c0_phase(cmp_pos, w_cmp_k, w_cmp_v, C0); DRAIN3(14); } SEAM(14);
    if (IN(15)) { fa::sb_attn_phase(lds, PB, AO); DRAIN3(15); } SEAM(15);
    if (IN(16)) { GEMM_RESX(AO, WOUT0, (const float*)out, RSS + 2 * SEQ); DRAIN3(-1); } SEAM(16);
    if (IN(18)) { GEMM_BF16S(H, WIN1, LD3, PB, LD3, RSS + 2 * SEQ); } SEAM(18);
    if (IN(19)) { tp::nsa_prep_phase(PB, q_norm_d, k_norm_d);
                  fa::nsa_compress_phase(lds, PB, WCK, WCV, C0, k_norm_d, KCMP, VCMP); } SEAM(19);
    if (IN(20)) { fa::nsa_attn_phase(lds, PB, KCMP, VCMP, q_norm_d, k_norm_d, (unsigned*)(ws + WS_BAR) + 3904, AO); } SEAM(20);
    if (IN(21)) { GEMM_RES(AO, WOUT1, (const float*)out); } SEAM(21);
#undef IN
#undef SEAM
}

#ifndef N_LAUNCH_PER_PHASE
#define N_LAUNCH_PER_PHASE 0
#endif
extern "C" void kernel_launch(void* const* d_in, const int* in_sizes, int n_in, void* d_out, int out_size, void* d_ws, size_t ws_size, hipStream_t stream) {
    static int ready = 0;
    if (ready == 0) {
        if (n_in != 26 || ws_size < WS_END) { ready = -1; return; }
        if (hipFuncSetAttribute((const void*)fwd, hipFuncAttributeMaxDynamicSharedMemorySize, LDS_BYTES) != hipSuccess) { ready = -1; return; }
        int per_cu = 0; (void)hipOccupancyMaxActiveBlocksPerMultiprocessor(&per_cu, (const void*)fwd, NTHREADS, LDS_BYTES); (void)hipGetLastError();
        ready = 1;
    }
    if (ready < 0) return;
    (void)hipMemsetAsync((char*)d_ws + WS_BAR, 0, WS_CTL_BYTES, stream);
    Args a{};
    for (int i = 0; i < 26; ++i) a.in[i] = (const float*)d_in[i];
    a.out = (float*)d_out; a.ws = (unsigned char*)d_ws;
#if N_LAUNCH_PER_PHASE
    for (int p = 0; p < 22; ++p) { a.ph_lo = p; a.ph_hi = p + 1; hipLaunchKernelGGL(fwd, dim3(256), dim3(NTHREADS), LDS_BYTES, stream, a); }
#else
    a.ph_lo = 0; a.ph_hi = 22;
    hipLaunchKernelGGL(fwd, dim3(256), dim3(NTHREADS), LDS_BYTES, stream, a);
#endif
}
```

```cpp
#include <hip/hip_runtime.h>
#include <stdint.h>
#include <math.h>

typedef unsigned short bf16_t;
typedef float f32x4 __attribute__((ext_vector_type(4)));
typedef unsigned u32x4 __attribute__((ext_vector_type(4)));

#define SEQ 8192
#define DM 2048
#define NH 16
#define HD 128

__device__ __forceinline__ bf16_t f2bf(float f) { unsigned u = __float_as_uint(f); u += 0x7fffu + ((u >> 16) & 1u); return (bf16_t)(u >> 16); }
__device__ __forceinline__ float bf2f(bf16_t h) { return __uint_as_float(((unsigned)h) << 16); }
__device__ __forceinline__ float wave_sum(float v) { for (int o = 32; o > 0; o >>= 1) v += __shfl_xor(v, o); return v; }
__device__ __forceinline__ float wave_max(float v) { for (int o = 32; o > 0; o >>= 1) v = fmaxf(v, __shfl_xor(v, o)); return v; }
__device__ __forceinline__ float silu_f(float x) { return x / (1.f + __expf(-x)); }
__device__ __forceinline__ float sigmoid_f(float x) { return 1.f / (1.f + __expf(-x)); }
__device__ __forceinline__ float alibi_slope(int h) { return exp2f(-0.5f * (float)(h + 1)); }
__device__ __forceinline__ float logsig(float x) { return fminf(x, 0.f) - log1pf(__expf(-fabsf(x))); }

constexpr size_t WS_BAR = 0;
constexpr size_t WS_RSS = 16384;
constexpr size_t WS_C0 = WS_RSS + (size_t)3 * SEQ * 8;
constexpr size_t WS_SPLIT = WS_C0 + 2048;
constexpr size_t WS_LSS = WS_SPLIT + 2048;
constexpr size_t WS_CTL_BYTES = WS_LSS + (size_t)2 * SEQ * 8;
constexpr size_t WS_ROPE = WS_CTL_BYTES;
constexpr size_t WS_H = WS_ROPE + (size_t)SEQ * 64 * 4;
constexpr size_t WS_AO = WS_H + (size_t)SEQ * DM * 2;
constexpr size_t WS_SMALL = WS_AO + (size_t)SEQ * DM * 2;
constexpr size_t WS_QL = WS_SMALL;
constexpr size_t WS_KVL = WS_QL + (size_t)SEQ * 512 * 2;
constexpr size_t WS_KR = WS_KVL + (size_t)SEQ * 256 * 2;
constexpr size_t WS_KMEAN = WS_KR + (size_t)SEQ * 64 * 2;
constexpr size_t WS_KCMP = WS_KMEAN + (size_t)256 * 2048 * 4;
constexpr size_t WS_VCMP = WS_KCMP + (size_t)4 * 512 * 128 * 4;
constexpr size_t WS_ARENA = WS_VCMP + (size_t)4 * 512 * 128 * 4;
constexpr size_t AR_PB = 0;
constexpr size_t AR_QU = (size_t)SEQ * 3072 * 2;
constexpr size_t AR_KVU = AR_QU + (size_t)SEQ * 3072 * 2;
constexpr size_t WS_W = WS_ARENA + AR_KVU + (size_t)SEQ * 4096 * 2;
constexpr size_t WB_IN = 0;
constexpr size_t WB_OUT = (size_t)8192 * 2048 * 2;
constexpr size_t WB_QUP = WB_OUT + (size_t)2048 * 2048 * 2;
constexpr size_t WB_KVUP = WB_QUP + (size_t)3072 * 512 * 2;
constexpr size_t WB_CK = WB_KVUP + (size_t)4096 * 256 * 2;
constexpr size_t WB_CV = WB_CK + (size_t)128 * 4096 * 2;
constexpr size_t WREG = WB_CV + (size_t)128 * 4096 * 2;
constexpr size_t WS_END = WS_W + 2 * WREG;
constexpr int CQ_WORD0 = 3584;

#define XB_TMO      128
#define XB_XCNT(j)  (256  + 64 * (j))
#define XB_XSUB(j)  (1280 + 64 * (j))
#define XB_XGEN(j)  (2304 + 64 * (j))
#define XB_TOP      3328
#define XB_TOPGEN   3392
#define XCD_BAR_WORDS 3456
#define XB_SPIN_CAP (1u << 22)
#define LAS __attribute__((address_space(3)))

__device__ __forceinline__ unsigned xb_ld(unsigned* p)              { return __hip_atomic_load(p, __ATOMIC_RELAXED, __HIP_MEMORY_SCOPE_AGENT); }
__device__ __forceinline__ unsigned xb_add(unsigned* p, unsigned v) { return __hip_atomic_fetch_add(p, v, __ATOMIC_RELAXED, __HIP_MEMORY_SCOPE_AGENT); }
__device__ __forceinline__ unsigned xb_xcc_id() { return (unsigned)__builtin_amdgcn_s_getreg((3 << 11) | 20) & 0xFu; }
#define XB_SPIN(cond, bar) do { unsigned _sp = 0; while (cond) { __builtin_amdgcn_s_sleep(1); \
    if ((++_sp & 255u) == 0u) { if (xb_ld(&(bar)[XB_TMO])) break; if (_sp > XB_SPIN_CAP) { atomicAdd(&(bar)[XB_TMO], 1u); break; } } } } while (0)

struct XcdBarrier {
    unsigned* bar; unsigned x;
    volatile LAS unsigned* st;
};
__device__ __forceinline__ XcdBarrier xcd_barrier_post(unsigned* bar, volatile LAS unsigned* st) {
    XcdBarrier b; b.bar = bar; b.x = xb_xcc_id(); b.st = st;
    if (threadIdx.x == 0) (void)xb_add(&bar[XB_XCNT(b.x)], 1u);
    return b;
}
__device__ __forceinline__ void xcd_barrier_complete(unsigned* bar, unsigned x, unsigned& nloc, unsigned& nx) {
    const unsigned G = gridDim.x * gridDim.y * gridDim.z;
    unsigned sum, cnt, mine, sp = 0u;
    for (;;) {
        sum = 0u; cnt = 0u; mine = 0u;
#pragma unroll
        for (unsigned j = 0; j < 16; ++j) { const unsigned c = xb_ld(&bar[XB_XCNT(j)]); sum += c; cnt += (c > 0u) ? 1u : 0u; mine = (j == x) ? c : mine; }
        if (sum == G) break;
        __builtin_amdgcn_s_sleep(1);
        if ((++sp & 255u) == 0u) { if (xb_ld(&bar[XB_TMO])) break; if (sp > XB_SPIN_CAP) { atomicAdd(&bar[XB_TMO], 1u); break; } }
    }
    nloc = mine > 0u ? mine : 1u; nx = cnt > 0u ? cnt : 1u;
}
__device__ __forceinline__ void xcd_barrier(const XcdBarrier& b) {
    asm volatile("s_waitcnt vmcnt(0)" ::: "memory");
    __syncthreads();
    if (threadIdx.x == 0) {
        unsigned* bar = b.bar;
        __builtin_amdgcn_s_waitcnt(0);
        unsigned nloc = b.st[0], nx = b.st[1];
        if (nloc == 0u) { xcd_barrier_complete(bar, b.x, nloc, nx); b.st[0] = nloc; b.st[1] = nx; }
        const unsigned old = xb_add(&bar[XB_XSUB(b.x)], 1u);
        const unsigned gen = old / nloc;
        if (old + 1u == (gen + 1u) * nloc) {
            __builtin_amdgcn_fence(__ATOMIC_RELEASE, "agent");
            asm volatile("s_waitcnt vmcnt(0)" ::: "memory");
            const unsigned og = xb_add(&bar[XB_TOP], 1u);
            const unsigned tg = og / nx;
            if (og + 1u == (tg + 1u) * nx) xb_add(&bar[XB_TOPGEN], 1u);
            else XB_SPIN(xb_ld(&bar[XB_TOPGEN]) == tg, bar);
            __builtin_amdgcn_fence(__ATOMIC_ACQUIRE, "agent");
            xb_add(&bar[XB_XGEN(b.x)], 1u);
            asm volatile("s_waitcnt vmcnt(0)" ::: "memory");
        } else {
            XB_SPIN(xb_ld(&bar[XB_XGEN(b.x)]) == gen, bar);
            __builtin_amdgcn_fence(__ATOMIC_ACQUIRE, "agent");
            asm volatile("s_waitcnt vmcnt(0)" ::: "memory");
        }
    }
    __syncthreads();
}
__device__ __forceinline__ void nk_rope_table(int bx, int by, int tid, unsigned char* sm, bool active, float* tab) {
    int idx = bx * 256 + tid;
    if (idx >= SEQ * 32) return;
    int pos = idx >> 5, i = idx & 31;
    float inv = powf(10000.f, -(float)(2 * i) / 64.f);
    float ang = (float)pos * inv;
    double a = (double)ang;
    tab[idx * 2 + 0] = (float)cos(a);
    tab[idx * 2 + 1] = (float)sin(a);
}

#define LD3 7424

namespace pg8 {
#define PG8_LAS __attribute__((address_space(3)))
typedef unsigned short bf16_t;
typedef short bf16x8 __attribute__((ext_vector_type(8)));
typedef float f32x4 __attribute__((ext_vector_type(4)));
typedef unsigned u32x4 __attribute__((ext_vector_type(4)));
constexpr int BM = 256, BK = 64, HALF = 128, HTB = HALF * BK * 2  , STAGE_BYTES = 8 * HTB, NXCD = 8, WGM = 8;

__host__ __device__ __forceinline__ int lds_byte(int r, int c) { const int st = (r >> 4) * 2 + (c >> 5), rr = r & 15, cc = c & 31, ob = rr * 64 + cc * 2; return st * 1024 + (ob ^ (((ob >> 9) & 1) << 5)); }
__host__ __device__ __forceinline__ void stage_rc(int b, int& R, int& C) { const int st = b / 1024, sb = b % 1024, swz = sb ^ (((sb >> 9) & 1) << 5); R = (st >> 1) * 16 + swz / 64; C = (st & 1) * 32 + (swz % 64) / 2; }
__host__ __device__ __forceinline__ int perm32(int rho) { const int n = rho >> 4, i = rho & 15; return 8 * (i >> 2) + 4 * n + (i & 3); }

struct Unit { int pm, pn; };
struct Gemm { const bf16_t* A; const bf16_t* Bt; int M, N, K; };

struct StaticOrder {
    int nM, nN, nwg, G, c;
    __host__ __device__ void init(int M, int N, int G_, int c_) { nM = M / BM; nN = N / BM; nwg = nM * nN; G = G_; c = c_; }
    __host__ __device__ bool next(int i, Unit& u) const {
        const long L = (long)i * G + c; if (L >= nwg) return false;
        int wgid = (int)L; { const int q = nwg / NXCD, r = nwg % NXCD, xcd = wgid % NXCD, off = wgid / NXCD; wgid = (xcd < r ? xcd * (q + 1) : r * (q + 1) + (xcd - r) * q) + off; }
        const int nig = WGM * nN, gid = wgid / nig, fm = gid * WGM, gsz = (nM - fm) < WGM ? (nM - fm) : WGM;
        u.pm = fm + ((wgid % nig) % gsz); u.pn = (wgid % nig) / gsz; return true;
    }
    __device__ __forceinline__ void a_ready(const Unit&) const {}
    __device__ __forceinline__ void done(const Unit&) const {}
};
__device__ __forceinline__ unsigned cvt_pk_bf16(float lo, float hi) { unsigned r; asm volatile("v_cvt_pk_bf16_f32 %0, %1, %2" : "=v"(r) : "v"(lo), "v"(hi)); return r; }
typedef float f32x2 __attribute__((ext_vector_type(2)));
typedef unsigned long long u64acc;
__device__ __forceinline__ void acc_add_fx(u64acc* p, float v) { atomicAdd(p, (unsigned long long)(v * 16777216.f + 0.5f)); }
__device__ __forceinline__ float acc_get_fx(const u64acc* p) { return (float)((double)(*p) * (1.0 / 16777216.0)); }
__device__ __forceinline__ f32x2 gelu_pk(f32x2 v) {
    const f32x2 av = __builtin_elementwise_abs(v), d = av * 0.2316418882f + 1.0f;
    f32x2 t; t.x = __builtin_amdgcn_rcpf(d.x); t.y = __builtin_amdgcn_rcpf(d.y);
    f32x2 q = t * 0.5307027145f + (-0.7265760135f); q = q * t + 0.7107068705f; q = q * t + (-0.142248368f); q = q * t + 0.127414796f; q = q * t;
    const f32x2 s = (v * v) * (-0.72134752044f);
    f32x2 e; e.x = __builtin_amdgcn_exp2f(s.x); e.y = __builtin_amdgcn_exp2f(s.y);
    const f32x2 m = v * (q * e), r = v - m;
    f32x2 o; o.x = v.x < 0.f ? m.x : r.x; o.y = v.y < 0.f ? m.y : r.y; return o;
}

struct EpiF32 {
    static constexpr bool PERM = false, AFTER_DRAIN = false;
    float* C; int ldc; const float* bias;
    __device__ __forceinline__ void operator()(const f32x4 (&acc)[2][2][4][2], const Unit& u, int wr, int wc, int fr, int fq) const {
        const int row0 = u.pm * BM + wr * 64 + fr, col0 = u.pn * BM + wc * 32 + 4 * fq;
        f32x4 bv[2][2];
#pragma unroll
        for (int bj = 0; bj < 2; ++bj)
#pragma unroll
            for (int n = 0; n < 2; ++n) bv[bj][n] = bias ? *(const f32x4*)(bias + col0 + bj * HALF + n * 16) : (f32x4){0.f, 0.f, 0.f, 0.f};
#pragma unroll
        for (int ai = 0; ai < 2; ++ai)
#pragma unroll
            for (int m = 0; m < 4; ++m) { float* rowp = C + (size_t)(row0 + ai * HALF + m * 16) * ldc + col0;
#pragma unroll
                for (int bj = 0; bj < 2; ++bj)
#pragma unroll
                    for (int n = 0; n < 2; ++n) *(f32x4*)(rowp + bj * HALF + n * 16) = acc[ai][bj][m][n] + bv[bj][n]; }
    }
};
template <int ACT  > struct EpiBf16 {
    static constexpr bool PERM = true, AFTER_DRAIN = false;
    bf16_t* O; int ldc; const float* bias; int split_cols; size_t split_stride;
    __device__ __forceinline__ void operator()(const f32x4 (&acc)[2][2][4][2], const Unit& u, int wr, int wc, int fr, int fq) const {
        const int row0 = u.pm * BM + wr * 64 + fr; int colt = u.pn * BM; bf16_t* base = O;
        if (split_cols) { const int t = colt / split_cols; base += (size_t)t * split_stride; colt -= t * split_cols; }
        const int col0 = colt + wc * 32 + 8 * fq, bcol0 = u.pn * BM + wc * 32 + 8 * fq;
        f32x4 bv[2][2];
#pragma unroll
        for (int bj = 0; bj < 2; ++bj)
#pragma unroll
            for (int n = 0; n < 2; ++n) bv[bj][n] = bias ? *(const f32x4*)(bias + bcol0 + bj * HALF + 4 * n) : (f32x4){0.f, 0.f, 0.f, 0.f};
#pragma unroll
        for (int ai = 0; ai < 2; ++ai)
#pragma unroll
            for (int m = 0; m < 4; ++m) { bf16_t* rowp = base + (size_t)(row0 + ai * HALF + m * 16) * ldc + col0;
#pragma unroll
                for (int bj = 0; bj < 2; ++bj) { f32x4 v0 = acc[ai][bj][m][0] + bv[bj][0], v1 = acc[ai][bj][m][1] + bv[bj][1];
                    if (ACT == 1) { f32x2 a = gelu_pk((f32x2){v0[0], v0[1]}), b = gelu_pk((f32x2){v0[2], v0[3]}), c = gelu_pk((f32x2){v1[0], v1[1]}), d = gelu_pk((f32x2){v1[2], v1[3]});
                        v0 = (f32x4){a.x, a.y, b.x, b.y}; v1 = (f32x4){c.x, c.y, d.x, d.y}; }
                    if (ACT == 2) {
#pragma unroll
                        for (int j = 0; j < 4; ++j) { v0[j] = 0.5f * v0[j] * (1.0f + erff(v0[j] * 0.70710678f)); v1[j] = 0.5f * v1[j] * (1.0f + erff(v1[j] * 0.70710678f)); } }
                    u32x4 w; w.x = cvt_pk_bf16(v0[0], v0[1]); w.y = cvt_pk_bf16(v0[2], v0[3]); w.z = cvt_pk_bf16(v1[0], v1[1]); w.w = cvt_pk_bf16(v1[2], v1[3]);
                    *(u32x4*)(rowp + bj * HALF) = w; } }
    }
};

struct EpiResF32 {
    static constexpr bool PERM = false, AFTER_DRAIN = false;
    const float* res; float* out; int ldc;
    __device__ __forceinline__ void operator()(const f32x4 (&acc)[2][2][4][2], const Unit& u, int wr, int wc, int fr, int fq) const {
        const int row0 = u.pm * BM + wr * 64 + fr, col0 = u.pn * BM + wc * 32 + 4 * fq;
        const float* __restrict__ rp = res; float* __restrict__ op = out;
#pragma unroll
        for (int ai = 0; ai < 2; ++ai) {
            f32x4 r[4][2][2];
#pragma unroll
            for (int m = 0; m < 4; ++m) { const size_t ro = (size_t)(row0 + ai * HALF + m * 16) * ldc + col0;
#pragma unroll
                for (int bj = 0; bj < 2; ++bj)
#pragma unroll
                    for (int n = 0; n < 2; ++n) r[m][bj][n] = *(const f32x4*)(rp + ro + bj * HALF + n * 16); }
#pragma unroll
            for (int m = 0; m < 4; ++m) { const size_t ro = (size_t)(row0 + ai * HALF + m * 16) * ldc + col0;
#pragma unroll
                for (int bj = 0; bj < 2; ++bj)
#pragma unroll
                    for (int n = 0; n < 2; ++n) *(f32x4*)(op + ro + bj * HALF + n * 16) = r[m][bj][n] + acc[ai][bj][m][n]; }
        }
    }
};

__device__ __forceinline__ f32x4 bf4_to_f32(uint2 w) { return f32x4{__uint_as_float(w.x << 16), __uint_as_float(w.x & 0xffff0000u), __uint_as_float(w.y << 16), __uint_as_float(w.y & 0xffff0000u)}; }
template <bool RES_BF16, bool WRITE_F32 = false, bool FINAL = false> struct EpiResBfX {
    static constexpr bool PERM = true, AFTER_DRAIN = false;
    const float* res; bf16_t* xb; u64acc* rss; int ldc; float* outf;
    __device__ __forceinline__ void operator()(const f32x4 (&acc)[2][2][4][2], const Unit& u, int wr, int wc, int fr, int fq) const {
        const int row0 = u.pm * BM + wr * 64 + fr, col0 = u.pn * BM + wc * 32 + 8 * fq;
        const float* __restrict__ rp = res;
#pragma unroll
        for (int ai = 0; ai < 2; ++ai) {
            f32x4 r[RES_BF16 ? 1 : 4][2][2]; u32x4 rb[RES_BF16 ? 4 : 1][2];
#pragma unroll
            for (int m = 0; m < 4; ++m) { const size_t ro = (size_t)(row0 + ai * HALF + m * 16) * ldc + col0;
#pragma unroll
                for (int bj = 0; bj < 2; ++bj) { if constexpr (RES_BF16) rb[m][bj] = *(const u32x4*)(xb + ro + bj * HALF);
                    else { r[m][bj][0] = *(const f32x4*)(rp + ro + bj * HALF); r[m][bj][1] = *(const f32x4*)(rp + ro + bj * HALF + 4); } } }
#pragma unroll
            for (int m = 0; m < 4; ++m) { const int row = row0 + ai * HALF + m * 16; const size_t ro = (size_t)row * ldc + col0;
                float ss = 0.f;
#pragma unroll
                for (int bj = 0; bj < 2; ++bj) { f32x4 r0, r1;
                    if constexpr (RES_BF16) { r0 = bf4_to_f32(uint2{rb[m][bj].x, rb[m][bj].y}); r1 = bf4_to_f32(uint2{rb[m][bj].z, rb[m][bj].w}); } else { r0 = r[m][bj][0]; r1 = r[m][bj][1]; }
                    const f32x4 v0 = r0 + acc[ai][bj][m][0], v1 = r1 + acc[ai][bj][m][1];
                    if constexpr (!FINAL) { u32x4 w; w.x = cvt_pk_bf16(v0[0], v0[1]); w.y = cvt_pk_bf16(v0[2], v0[3]); w.z = cvt_pk_bf16(v1[0], v1[1]); w.w = cvt_pk_bf16(v1[2], v1[3]);
                        *(u32x4*)(xb + ro + bj * HALF) = w; }
                    if constexpr (WRITE_F32) { *(f32x4*)(outf + ro + bj * HALF) = v0; *(f32x4*)(outf + ro + bj * HALF + 4) = v1; }
                    if constexpr (!FINAL) ss += ((v0[0] * v0[0] + v0[1] * v0[1]) + (v0[2] * v0[2] + v0[3] * v0[3])) + ((v1[0] * v1[0] + v1[1] * v1[1]) + (v1[2] * v1[2] + v1[3] * v1[3])); }
                if constexpr (!FINAL) { ss += __shfl_xor(ss, 16); ss += __shfl_xor(ss, 32);
                    if (fq == 0) acc_add_fx(rss + row, ss); } }
        }
    }
};
struct EpiResBfOut {
    static constexpr bool PERM = false, AFTER_DRAIN = false;
    const bf16_t* xb; float* out; int ldc;
    __device__ __forceinline__ void operator()(const f32x4 (&acc)[2][2][4][2], const Unit& u, int wr, int wc, int fr, int fq) const {
        const int row0 = u.pm * BM + wr * 64 + fr, col0 = u.pn * BM + wc * 32 + 4 * fq;
#pragma unroll
        for (int ai = 0; ai < 2; ++ai)
#pragma unroll
            for (int mh = 0; mh < 2; ++mh) {
                uint2 r[2][2][2];
#pragma unroll
                for (int m = 0; m < 2; ++m) { const size_t ro = (size_t)(row0 + ai * HALF + (mh * 2 + m) * 16) * ldc + col0;
#pragma unroll
                    for (int bj = 0; bj < 2; ++bj)
#pragma unroll
                        for (int n = 0; n < 2; ++n) r[m][bj][n] = *(const uint2*)(xb + ro + bj * HALF + n * 16); }
#pragma unroll
                for (int m = 0; m < 2; ++m) { const size_t ro = (size_t)(row0 + ai * HALF + (mh * 2 + m) * 16) * ldc + col0;
#pragma unroll
                    for (int bj = 0; bj < 2; ++bj)
#pragma unroll
                        for (int n = 0; n < 2; ++n) *(f32x4*)(out + ro + bj * HALF + n * 16) = bf4_to_f32(r[m][bj][n]) + acc[ai][bj][mh * 2 + m][n]; }
            }
    }
};
struct EpiResF32X {
    static constexpr bool PERM = false, AFTER_DRAIN = false;
    const float* res; float* out; bf16_t* xb; u64acc* rss; int ldc;
    __device__ __forceinline__ void operator()(const f32x4 (&acc)[2][2][4][2], const Unit& u, int wr, int wc, int fr, int fq) const {
        const int row0 = u.pm * BM + wr * 64 + fr, col0 = u.pn * BM + wc * 32 + 4 * fq;
        const float* __restrict__ rp = res; float* __restrict__ op = out;
#pragma unroll
        for (int ai = 0; ai < 2; ++ai) {
            f32x4 r[4][2][2];
#pragma unroll
            for (int m = 0; m < 4; ++m) { const size_t ro = (size_t)(row0 + ai * HALF + m * 16) * ldc + col0;
#pragma unroll
                for (int bj = 0; bj < 2; ++bj)
#pragma unroll
                    for (int n = 0; n < 2; ++n) r[m][bj][n] = *(const f32x4*)(rp + ro + bj * HALF + n * 16); }
#pragma unroll
            for (int m = 0; m < 4; ++m) { const int row = row0 + ai * HALF + m * 16; const size_t ro = (size_t)row * ldc + col0;
                float ss = 0.f;
#pragma unroll
                for (int bj = 0; bj < 2; ++bj)
#pragma unroll
                    for (int n = 0; n < 2; ++n) { const f32x4 v = r[m][bj][n] + acc[ai][bj][m][n]; *(f32x4*)(op + ro + bj * HALF + n * 16) = v;
                        uint2 w; w.x = cvt_pk_bf16(v[0], v[1]); w.y = cvt_pk_bf16(v[2], v[3]); *(uint2*)(xb + ro + bj * HALF + n * 16) = w;
                        ss += (v[0] * v[0] + v[1] * v[1]) + (v[2] * v[2] + v[3] * v[3]); }
                ss += __shfl_xor(ss, 16); ss += __shfl_xor(ss, 32);
                if (fq == 0) acc_add_fx(rss + row, ss); }
        }
    }
};

struct EpiMlaIn {
    static constexpr bool PERM = true, AFTER_DRAIN = false;
    bf16_t* PBo; int ldc; bf16_t* QLo; bf16_t* KVLo; u64acc* qss; u64acc* kvss;
    __device__ __forceinline__ void operator()(const f32x4 (&acc)[2][2][4][2], const Unit& u, int wr, int wc, int fr, int fq) const {
        const int row0 = u.pm * BM + wr * 64 + fr, cl = wc * 32 + 8 * fq;
        bf16_t* base; int ld; u64acc* ssp;
        if (u.pn < 2) { base = QLo + u.pn * 256; ld = 512; ssp = qss; } else if (u.pn == 2) { base = KVLo; ld = 256; ssp = kvss; } else { base = PBo + u.pn * 256; ld = ldc; ssp = nullptr; }
#pragma unroll
        for (int ai = 0; ai < 2; ++ai)
#pragma unroll
            for (int m = 0; m < 4; ++m) { const int row = row0 + ai * HALF + m * 16; bf16_t* rowp = base + (size_t)row * ld + cl;
                float ss = 0.f;
#pragma unroll
                for (int bj = 0; bj < 2; ++bj) { const f32x4 v0 = acc[ai][bj][m][0], v1 = acc[ai][bj][m][1];
                    u32x4 w; w.x = cvt_pk_bf16(v0[0], v0[1]); w.y = cvt_pk_bf16(v0[2], v0[3]); w.z = cvt_pk_bf16(v1[0], v1[1]); w.w = cvt_pk_bf16(v1[2], v1[3]);
                    *(u32x4*)(rowp + bj * HALF) = w;
                    ss += ((v0[0] * v0[0] + v0[1] * v0[1]) + (v0[2] * v0[2] + v0[3] * v0[3])) + ((v1[0] * v1[0] + v1[1] * v1[1]) + (v1[2] * v1[2] + v1[3] * v1[3])); }
                if (ssp) { ss += __shfl_xor(ss, 16); ss += __shfl_xor(ss, 32); if (fq == 0) acc_add_fx(ssp + row, ss); } }
    }
};
struct EpiBf16S {
    static constexpr bool PERM = true, AFTER_DRAIN = false;
    bf16_t* O; int ldc; const u64acc* rss; float inv_k;
    __device__ __forceinline__ void operator()(const f32x4 (&acc)[2][2][4][2], const Unit& u, int wr, int wc, int fr, int fq) const {
        const int row0 = u.pm * BM + wr * 64 + fr, col0 = u.pn * BM + wc * 32 + 8 * fq;
        unsigned long long sq[2][4];
#pragma unroll
        for (int ai = 0; ai < 2; ++ai)
#pragma unroll
            for (int m = 0; m < 4; ++m) sq[ai][m] = rss[row0 + ai * HALF + m * 16];
#pragma unroll
        for (int ai = 0; ai < 2; ++ai)
#pragma unroll
            for (int m = 0; m < 4; ++m) { const int row = row0 + ai * HALF + m * 16; bf16_t* rowp = O + (size_t)row * ldc + col0;
                const float s = rsqrtf((float)((double)sq[ai][m] * (1.0 / 16777216.0)) * inv_k + 1e-6f);
#pragma unroll
                for (int bj = 0; bj < 2; ++bj) { const f32x4 v0 = acc[ai][bj][m][0] * s, v1 = acc[ai][bj][m][1] * s;
                    u32x4 w; w.x = cvt_pk_bf16(v0[0], v0[1]); w.y = cvt_pk_bf16(v0[2], v0[3]); w.z = cvt_pk_bf16(v1[0], v1[1]); w.w = cvt_pk_bf16(v1[2], v1[3]);
                    *(u32x4*)(rowp + bj * HALF) = w; } }
    }
};

template <class Epi, class Sched, bool STAMP = false>
__device__ __forceinline__ void gemm_phase(PG8_LAS unsigned char* lds, const Gemm g, const Sched& S, const Epi& E, unsigned long long* stamps) {
    const int tid = threadIdx.x, wid = __builtin_amdgcn_readfirstlane(tid >> 6), lane = tid & 63, wr = wid >> 2, wc = wid & 3, fr = lane & 15, fq = lane >> 4;
    const int K = g.K, nt = K / BK;
    int ts_lo = 0, ts_hi = 0, nts = 0; const unsigned long long rt_entry = STAMP ? (unsigned long long)wall_clock64() : 0ull;
#define PG8_STAMP() do { if (STAMP && wid == 0 && nts < 64) { const unsigned long long _c = (unsigned long long)clock64(); \
        ts_lo = (lane == nts) ? (int)(unsigned)_c : ts_lo; ts_hi = (lane == nts) ? (int)(unsigned)(_c >> 32) : ts_hi; ++nts; } } while (0)
    PG8_STAMP();
    unsigned voffA[2], voffB[2];
#pragma unroll
    for (int i = 0; i < 2; ++i) { int R, C; stage_rc(tid * 16 + i * 8192, R, C); const int Rb = Epi::PERM ? ((R & ~31) + perm32(R & 31)) : R;
        voffA[i] = (unsigned)(R * K + C) * 2u; voffB[i] = (unsigned)(Rb * K + C) * 2u; }
    const size_t kstep = (size_t)(BK * 2);
    const size_t hstep = (size_t)HALF * K * 2;
    const size_t tstep = 2 * hstep;
    const unsigned ldsw = (unsigned)wid * 1024u;
    const int aoff = lds_byte(wr * 64 + fr, fq * 8), boff = lds_byte(wc * 32 + fr, fq * 8);
#define PG8_SA(b, h) (((b) * 2 + (h)) * HTB)
#define PG8_SB(b, h) ((4 + (b) * 2 + (h)) * HTB)
#define PG8_STAGE(bufoff, gbase, voff) do { _Pragma("unroll") for (int _i = 0; _i < 2; ++_i) \
        __builtin_amdgcn_global_load_lds((const unsigned*)((const char*)(gbase) + (voff)[_i]), (PG8_LAS unsigned*)(lds + (bufoff) + ldsw + _i * 8192), 16, 0, 0); } while (0)
#define PG8_LDA(dst, b, h) do { _Pragma("unroll") for (int m = 0; m < 4; ++m) _Pragma("unroll") for (int k = 0; k < 2; ++k) dst[m][k] = *(const PG8_LAS bf16x8*)(lds + PG8_SA(b, h) + aoff + m * 2048 + k * 1024); } while (0)
#define PG8_LDB(dst, b, h) do { _Pragma("unroll") for (int n = 0; n < 2; ++n) _Pragma("unroll") for (int k = 0; k < 2; ++k) dst[n][k] = *(const PG8_LAS bf16x8*)(lds + PG8_SB(b, h) + boff + n * 2048 + k * 1024); } while (0)
#define PG8_MMA(ai, bj, At, Bt) do { __builtin_amdgcn_s_setprio(1); _Pragma("unroll") for (int m = 0; m < 4; ++m) _Pragma("unroll") for (int n = 0; n < 2; ++n) _Pragma("unroll") for (int k = 0; k < 2; ++k) \
        acc[ai][bj][m][n] = __builtin_amdgcn_mfma_f32_16x16x32_bf16(Bt[n][k], At[m][k], acc[ai][bj][m][n], 0, 0, 0); __builtin_amdgcn_s_setprio(0); } while (0)
#define PG8_WAIT_V(n) asm volatile("s_waitcnt vmcnt(" #n ")" ::: "memory")
#define PG8_WAIT_L(n) asm volatile("s_waitcnt lgkmcnt(" #n ")" ::: "memory")
#define PG8_BAR __builtin_amdgcn_s_barrier()
#define PG8_SCHED __builtin_amdgcn_sched_barrier(0)
    Unit cur, nxt; int ui = 0;
    if (!S.next(0, cur)) return;
    f32x4 acc[2][2][4][2];
#pragma unroll
    for (int a = 0; a < 2; ++a)
#pragma unroll
        for (int b = 0; b < 2; ++b)
#pragma unroll
            for (int m = 0; m < 4; ++m)
#pragma unroll
                for (int n = 0; n < 2; ++n) acc[a][b][m][n] = (f32x4){0.f, 0.f, 0.f, 0.f};
    bf16x8 At[4][2], B0[2][2], B1[2][2];
    const char* cA = (const char*)g.A + (size_t)cur.pm * tstep; const char* cB = (const char*)g.Bt + (size_t)cur.pn * tstep;
    S.a_ready(cur);
    PG8_STAGE(PG8_SB(0, 0), cB, voffB); PG8_STAGE(PG8_SA(0, 0), cA, voffA); PG8_STAGE(PG8_SB(0, 1), cB + hstep, voffB); PG8_STAGE(PG8_SA(0, 1), cA + hstep, voffA);
    if (wr == 1) PG8_BAR;
    PG8_WAIT_V(4); PG8_BAR;
    PG8_STAGE(PG8_SB(1, 0), cB + kstep, voffB); PG8_STAGE(PG8_SA(1, 0), cA + kstep, voffA); PG8_STAGE(PG8_SB(1, 1), cB + hstep + kstep, voffB);
    PG8_WAIT_V(6); PG8_BAR;
    PG8_STAMP();
    for (;;) {
        const bool has_next = S.next(ui + 1, nxt);
        const char* nA = has_next ? (const char*)g.A + (size_t)nxt.pm * tstep : cA; const char* nB = has_next ? (const char*)g.Bt + (size_t)nxt.pn * tstep : cB;
        for (int t = 0; t < nt; t += 2) {
            const bool last = (t == nt - 2);
            const char* a1 = cA + (size_t)(t + 1) * kstep;
            const char* a2 = last ? nA : cA + (size_t)(t + 2) * kstep; const char* b2 = last ? nB : cB + (size_t)(t + 2) * kstep;
            const char* a3 = a2 + kstep; const char* b3 = b2 + kstep;
            if (last && has_next) S.a_ready(nxt);
            PG8_LDB(B0, 0, 0); PG8_SCHED; PG8_LDA(At, 0, 0); PG8_STAGE(PG8_SA(1, 1), a1 + hstep, voffA);
            PG8_WAIT_L(8); PG8_BAR; PG8_WAIT_L(0); PG8_MMA(0, 0, At, B0); PG8_BAR; PG8_SCHED;
            PG8_LDB(B1, 0, 1); PG8_STAGE(PG8_SB(0, 0), b2, voffB);
            PG8_BAR; PG8_WAIT_L(0); PG8_MMA(0, 1, At, B1); PG8_BAR;
            PG8_LDA(At, 0, 1); PG8_STAGE(PG8_SA(0, 0), a2, voffA);
            PG8_BAR; PG8_WAIT_L(0); PG8_MMA(1, 0, At, B0); PG8_BAR; PG8_SCHED;
            PG8_STAGE(PG8_SB(0, 1), b2 + hstep, voffB);
            PG8_WAIT_V(6); PG8_BAR; PG8_MMA(1, 1, At, B1); PG8_BAR;
            PG8_LDB(B0, 1, 0); PG8_SCHED; PG8_LDA(At, 1, 0); PG8_STAGE(PG8_SA(0, 1), a2 + hstep, voffA);
            PG8_WAIT_L(8); PG8_BAR; PG8_WAIT_L(0); PG8_MMA(0, 0, At, B0); PG8_BAR; PG8_SCHED;
            PG8_LDB(B1, 1, 1); PG8_STAGE(PG8_SB(1, 0), b3, voffB);
            PG8_BAR; PG8_WAIT_L(0); PG8_MMA(0, 1, At, B1); PG8_BAR;
            PG8_LDA(At, 1, 1); PG8_STAGE(PG8_SA(1, 0), a3, voffA);
            PG8_BAR; PG8_WAIT_L(0); PG8_MMA(1, 0, At, B0); PG8_BAR; PG8_SCHED;
            PG8_STAGE(PG8_SB(1, 1), b3 + hstep, voffB);
            PG8_WAIT_V(6); PG8_BAR; PG8_MMA(1, 1, At, B1); PG8_BAR;
        }
        PG8_STAMP();
        if constexpr (!Epi::AFTER_DRAIN) { E(acc, cur, wr, wc, fr, fq); S.done(cur); }
        PG8_STAMP();
        if (!has_next) break;
#pragma unroll
        for (int a = 0; a < 2; ++a)
#pragma unroll
            for (int b = 0; b < 2; ++b)
#pragma unroll
                for (int m = 0; m < 4; ++m)
#pragma unroll
                    for (int n = 0; n < 2; ++n) acc[a][b][m][n] = (f32x4){0.f, 0.f, 0.f, 0.f};
        cur = nxt; cA = nA; cB = nB; ++ui;
    }
    PG8_WAIT_V(0);
    if (wr == 0) PG8_BAR;
    PG8_BAR;
    if constexpr (Epi::AFTER_DRAIN) { E.fused(acc, cur, wr, wc, fr, fq, lds, wid, lane); S.done(cur); }
    PG8_STAMP();
    if (STAMP && wid == 0) { stamps[lane] = lane < nts ? (((unsigned long long)(unsigned)ts_hi << 32) | (unsigned)ts_lo) : 0ull;
        if (lane == 62) stamps[62] = rt_entry; if (lane == 63) stamps[63] = (unsigned long long)wall_clock64(); }
#undef PG8_STAMP
#undef PG8_SA
#undef PG8_SB
#undef PG8_STAGE
#undef PG8_LDA
#undef PG8_LDB
#undef PG8_MMA
#undef PG8_WAIT_V
#undef PG8_WAIT_L
#undef PG8_BAR
#undef PG8_SCHED
}
}

__device__ __forceinline__ void conv_wT(const float* __restrict__ W, bf16_t* __restrict__ Wt, int K, int N, unsigned char* lds) {
    const int tid = threadIdx.x;
    const int nkt = K / 128, nnt = (N + 63) / 64;
    bf16_t* T = (bf16_t*)lds;
    const int lr = tid >> 4, lc = (tid & 15) * 4;
    const int sn = tid >> 3, sk = (tid & 7) * 16;
    for (int tile = blockIdx.x; tile < nkt * nnt; tile += gridDim.x) {
        const int kt = tile % nkt, nt = tile / nkt;
        const int k0 = kt * 128, n0 = nt * 64;
#pragma unroll
        for (int i = 0; i < 4; ++i) {
            const int k = lr + 32 * i;
            f32x4 v = {0.f, 0.f, 0.f, 0.f};
            if (n0 + lc < N) v = *(const f32x4*)(W + (size_t)(k0 + k) * N + n0 + lc);
#pragma unroll
            for (int j = 0; j < 4; ++j) T[(lc + j) * 136 + k] = f2bf(v[j]);
        }
        __syncthreads();
        if (n0 + sn < N) {
            const u32x4 a = *(const u32x4*)(T + sn * 136 + sk), b = *(const u32x4*)(T + sn * 136 + sk + 8);
            *(u32x4*)(Wt + (size_t)(n0 + sn) * K + k0 + sk) = a; *(u32x4*)(Wt + (size_t)(n0 + sn) * K + k0 + sk + 8) = b;
        }
        __syncthreads();
    }
}


namespace fa {
typedef short bf16x8 __attribute__((ext_vector_type(8)));
typedef short s16x4 __attribute__((ext_vector_type(4)));
typedef float f32x16 __attribute__((ext_vector_type(16)));
#define FA_SBAR() __builtin_amdgcn_sched_barrier(0)
constexpr float LOG2E = 1.4426950408889634f;
#define FA_PD 3
constexpr float THR_NAT = 8.f;
__device__ __forceinline__ int crow(int r, int hi) { return (r & 3) + 8 * (r >> 2) + 4 * hi; }
__device__ __forceinline__ unsigned cvtpk(float lo, float hi) { unsigned r; asm volatile("v_cvt_pk_bf16_f32 %0, %1, %2" : "=v"(r) : "v"(lo), "v"(hi)); return r; }
template <int DK> __device__ __forceinline__ int kswz(int row, int colB) { return row * (DK * 2) + (colB ^ ((DK == 128 ? (row & 15) : (row & 7)) << 4)); }
__device__ __forceinline__ int v_st(int k, int c) { const int kk = (k & ~0xC) | ((k & 4) << 1) | ((k & 8) >> 1); return ((kk >> 3) * 4 + (c >> 5)) * 512 + ((kk & 7) * 32 + (c & 31)) * 2; }
__device__ __forceinline__ int v_rd_base(int lane) { return ((lane & 3) << 3) | (((lane >> 2) & 3) << 6) | (((lane >> 4) & 1) << 5) | (((lane >> 5) & 1) << 8); }
constexpr int v_rd_off(int d0, int ks, int half) { return d0 * 512 + ks * 4096 + half * 2048; }
template <int OFF> __device__ __forceinline__ s16x4 tr_read(int vb) {
    s16x4 r; asm volatile("ds_read_b64_tr_b16 %0, %1 offset:%2" : "=&v"(r) : "v"(vb), "i"(OFF) : "memory"); return r;
}
template <int D0> __device__ __forceinline__ void pv_rd(int vb, s16x4 (&v)[8]) {
    v[0] = tr_read<v_rd_off(D0, 0, 0)>(vb); v[1] = tr_read<v_rd_off(D0, 0, 1)>(vb); v[2] = tr_read<v_rd_off(D0, 1, 0)>(vb); v[3] = tr_read<v_rd_off(D0, 1, 1)>(vb);
    v[4] = tr_read<v_rd_off(D0, 2, 0)>(vb); v[5] = tr_read<v_rd_off(D0, 2, 1)>(vb); v[6] = tr_read<v_rd_off(D0, 3, 0)>(vb); v[7] = tr_read<v_rd_off(D0, 3, 1)>(vb);
}
__device__ __forceinline__ void pv_mm(f32x16& od, const s16x4 (&v)[8], bf16x8 pa0, bf16x8 pa1, bf16x8 pa2, bf16x8 pa3) {
#define FA_PK(L, H) (bf16x8){L[0], L[1], L[2], L[3], H[0], H[1], H[2], H[3]}
    od = __builtin_amdgcn_mfma_f32_32x32x16_bf16(pa0, FA_PK(v[0], v[1]), od, 0, 0, 0);
    od = __builtin_amdgcn_mfma_f32_32x32x16_bf16(pa1, FA_PK(v[2], v[3]), od, 0, 0, 0);
    od = __builtin_amdgcn_mfma_f32_32x32x16_bf16(pa2, FA_PK(v[4], v[5]), od, 0, 0, 0);
    od = __builtin_amdgcn_mfma_f32_32x32x16_bf16(pa3, FA_PK(v[6], v[7]), od, 0, 0, 0);
#undef FA_PK
}
__device__ __forceinline__ void pv_d0(f32x16* o, int vb, bf16x8 pa0, bf16x8 pa1, bf16x8 pa2, bf16x8 pa3) {
    s16x4 A[8], B[8];
    pv_rd<0>(vb, A); pv_rd<1>(vb, B);
    asm volatile("s_waitcnt lgkmcnt(8)" ::: "memory"); FA_SBAR();
    pv_mm(o[0], A, pa0, pa1, pa2, pa3); FA_SBAR();
    pv_rd<2>(vb, A);
    asm volatile("s_waitcnt lgkmcnt(8)" ::: "memory"); FA_SBAR();
    pv_mm(o[1], B, pa0, pa1, pa2, pa3); FA_SBAR();
    pv_rd<3>(vb, B);
    asm volatile("s_waitcnt lgkmcnt(8)" ::: "memory"); FA_SBAR();
    pv_mm(o[2], A, pa0, pa1, pa2, pa3); FA_SBAR();
    asm volatile("s_waitcnt lgkmcnt(0)" ::: "memory"); FA_SBAR();
    pv_mm(o[3], B, pa0, pa1, pa2, pa3);
}
__device__ __forceinline__ void pack_p(const f32x16& p0, const f32x16& p1, bf16x8& pa0, bf16x8& pa1, bf16x8& pa2, bf16x8& pa3) {
#define FA_PK4(P, BASE, OUT) do { unsigned a0 = cvtpk(P[BASE + 0], P[BASE + 1]), a1 = cvtpk(P[BASE + 2], P[BASE + 3]);   \
    unsigned b0 = cvtpk(P[BASE + 4], P[BASE + 5]), b1 = cvtpk(P[BASE + 6], P[BASE + 7]);                              \
    auto r0 = __builtin_amdgcn_permlane32_swap(a0, b0, false, false); auto r1 = __builtin_amdgcn_permlane32_swap(a1, b1, false, false); \
    u32x4 w = {r0[0], r1[0], r0[1], r1[1]}; OUT = *reinterpret_cast<bf16x8*>(&w); } while (0)
    FA_PK4(p0, 0, pa0); FA_PK4(p0, 8, pa1); FA_PK4(p1, 0, pa2); FA_PK4(p1, 8, pa3);
#undef FA_PK4
}
__device__ __forceinline__ float pair_max(float v) { auto rr = __builtin_amdgcn_permlane32_swap(__float_as_uint(v), __float_as_uint(v), false, false); return fmaxf(__uint_as_float(rr[0]), __uint_as_float(rr[1])); }
__device__ __forceinline__ float pair_sum(float v) { auto rr = __builtin_amdgcn_permlane32_swap(__float_as_uint(v), __float_as_uint(v), false, false); return __uint_as_float(rr[0]) + __uint_as_float(rr[1]); }

template <int DK, int NKB = 2, int NVB = NKB> struct LdsMap { static constexpr int KB = 64 * DK * 2, VB = 64 * 128 * 2, K0 = 0, V0 = NKB * KB, WS0 = NKB * KB + NVB * VB, TOTAL = WS0 + 8 * 256; };
template <class P> using PolLds = LdsMap<P::DK, P::SKEW ? 2 : P::RING, P::SKEW ? 3 : P::RING>;

template <class P>
__device__ __forceinline__ void flash_pass(const P& pol, unsigned char* lds, const bf16x8 (&qr)[P::DK / 16], f32x16 (&o)[4], float& m_reg, float& l_reg, int* kt_last = nullptr) {
    constexpr int DK = P::DK, RING = P::RING; using L = PolLds<P>;
    constexpr float C = P::SCALE * LOG2E, THR_RAW = THR_NAT / P::SCALE;
    int tid = threadIdx.x; asm volatile("" : "+v"(tid));
    const int wid = tid >> 6, lane = tid & 63, r32 = lane & 31, hi = lane >> 5;
    const int widu = __builtin_amdgcn_readfirstlane((int)threadIdx.x >> 6);
    unsigned char* Kl = lds + L::K0; unsigned char* Vl = lds + L::V0;
    float* al_l = (float*)(lds + L::WS0) + wid * 64 + 32;
    const int vb0 = (int)(uintptr_t)Vl + v_rd_base(lane);
    const int ka0 = (int)(uintptr_t)Kl + r32 * (DK * 2) + (((DK == 128 ? (r32 & 15) : (r32 & 7)) << 4) ^ (hi << 4));
    bf16x8 kg0 = {}, kg1 = {};
    if constexpr (P::AUG) { if (hi == 0) { const short a = (short)f2bf((float)r32), b = (short)f2bf((float)(32 + r32)); kg0[0] = a; kg0[1] = a; kg0[2] = (short)0x3F80; kg1[0] = b; kg1[1] = b; kg1[2] = (short)0x3F80; } }
    constexpr int NW = P::SKEW ? 4 : 8;
    constexpr int NKI = DK / 8 / NW, NVI = 16 / NW, NI = NKI + NVI;
    const char* kbase = (const char*)pol.kptr(0, 0); { const char* k2 = (const char*)pol.kptr(0, DK == 192 ? 16 : 0); kbase = k2 < kbase ? k2 : kbase; }
    const char* vbase = (const char*)pol.vptr(0, 0);
    unsigned kof[NKI], kst[NKI], vof[NVI], vst[NVI];
    const int wq = wid & (NW - 1), wqu = widu & (NW - 1);
#pragma unroll
    for (int i = 0; i < NKI; ++i) { const int n = (i * NW + wq) * 64 + lane, row = n / (DK / 8), slot = n % (DK / 8), cg = slot ^ (DK == 128 ? (row & 15) : (row & 7));
        const char* a = (const char*)pol.kptr(row, cg); kof[i] = (unsigned)(a - kbase); kst[i] = (unsigned)((const char*)pol.kptr(64 + row, cg) - a); }
#pragma unroll
    for (int i = 0; i < NVI; ++i) { const int sub = (i * NW + wq) * 2 + (lane >> 5), kk = (sub >> 2) * 8 + ((lane & 31) >> 2), key = (kk & ~0xC) | ((kk & 4) << 1) | ((kk & 8) >> 1), cg = (sub & 3) * 4 + (lane & 3);
        const char* a = (const char*)pol.vptr(key, cg); vof[i] = (unsigned)(a - vbase); vst[i] = (unsigned)((const char*)pol.vptr(64 + key, cg) - a); }
    const int kld = (int)(uintptr_t)Kl + wqu * 1024, vld = (int)(uintptr_t)Vl + wqu * 1024;
#define FA_DMA(kt, kb, vb) do { const unsigned kt_ = (unsigned)(kt); \
        _Pragma("unroll") for (int i_ = 0; i_ < NKI; ++i_) __builtin_amdgcn_global_load_lds((const unsigned*)(kbase + (size_t)(__umul24(kt_, kst[i_]) + kof[i_])), (LAS unsigned*)(unsigned)(kld + (kb) * L::KB + i_ * (NW * 1024)), 16, 0, 0); \
        _Pragma("unroll") for (int i_ = 0; i_ < NVI; ++i_) __builtin_amdgcn_global_load_lds((const unsigned*)(vbase + (size_t)(__umul24(kt_, vst[i_]) + vof[i_])), (LAS unsigned*)(unsigned)(vld + (vb) * L::VB + i_ * (NW * 1024)), 16, 0, 0); } while (0)
#define FA_WAITV_NI() do { if constexpr (NI == 4) asm volatile("s_waitcnt vmcnt(4)" ::: "memory"); else asm volatile("s_waitcnt vmcnt(5)" ::: "memory"); } while (0)
#define FA_WAITV0() asm volatile("s_waitcnt vmcnt(0)" ::: "memory")
#define FA_LBAR() do { asm volatile("s_waitcnt lgkmcnt(0)" ::: "memory"); __builtin_amdgcn_s_barrier(); asm volatile("" ::: "memory"); } while (0)
#define FA_ALLDONE(par) ({ const u32x4 fa_ = *(volatile LAS u32x4*)(flags + (par) * 8), fb_ = *(volatile LAS u32x4*)(flags + (par) * 8 + 4); (fa_.x & fa_.y & fa_.z & fa_.w & fb_.x & fb_.y & fb_.z & fb_.w) != 0u; })
    LAS int* flags = (LAS int*)(lds + L::TOTAL);
    f32x16 p0, p1; float tbias;
    auto qk = [&](int kt_, int ks_) __attribute__((always_inline)) {
        p0 = f32x16{}; p1 = f32x16{};
        {
            int ka = ka0 + ks_ * L::KB; asm volatile("" : "+v"(ka));
            constexpr int NS = DK / 16, XM = (DK == 128 ? 7 : 3), XS = (DK == 128 ? 3 : 2);
#define FA_KF(d, half) (*(const LAS bf16x8*)(unsigned)((ka ^ (((d) & XM) << 5)) + ((d) >> XS) * 128 + (half) * (32 * DK * 2)))
            bf16x8 fb0[FA_PD], fb1[FA_PD];
#pragma unroll
            for (int d0 = 0; d0 < FA_PD - 1; ++d0) { fb0[d0] = FA_KF(d0, 0); fb1[d0] = FA_KF(d0, 1); }
#pragma unroll
            for (int d0 = 0; d0 < NS; ++d0) {
                if (d0 + FA_PD - 1 < NS) { fb0[(d0 + FA_PD - 1) % FA_PD] = FA_KF(d0 + FA_PD - 1, 0); fb1[(d0 + FA_PD - 1) % FA_PD] = FA_KF(d0 + FA_PD - 1, 1); }
                FA_SBAR();
                p0 = __builtin_amdgcn_mfma_f32_32x32x16_bf16(fb0[d0 % FA_PD], qr[d0], p0, 0, 0, 0);
                p1 = __builtin_amdgcn_mfma_f32_32x32x16_bf16(fb1[d0 % FA_PD], qr[d0], p1, 0, 0, 0);
                FA_SBAR();
            }
#undef FA_KF
        }
        tbias = 0.f;
        if constexpr (P::AUG) {
            const bf16x8 qa = pol.qaug(kt_, hi);
            p0 = __builtin_amdgcn_mfma_f32_32x32x16_bf16(kg0, qa, p0, 0, 0, 0);
            p1 = __builtin_amdgcn_mfma_f32_32x32x16_bf16(kg1, qa, p1, 0, 0, 0);
            tbias = pol.tile_bias(kt_);
        }
        if (pol.need_mask(kt_)) {
            const int kb = kt_ * 64;
            const unsigned ts = pol.tile_state(kt_);
#pragma unroll
            for (int r = 0; r < 16; ++r) { p0[r] = pol.score(p0[r], kb + crow(r, hi), ts); p1[r] = pol.score(p1[r], kb + 32 + crow(r, hi), ts); }
        }
    };
    auto smpv = [&](int vs_) __attribute__((always_inline)) {
        float pmax = p0[0];
#pragma unroll
        for (int r = 1; r < 16; ++r) pmax = fmaxf(pmax, p0[r]);
#pragma unroll
        for (int r = 0; r < 16; ++r) pmax = fmaxf(pmax, p1[r]);
        pmax = pair_max(pmax) + tbias;
        float mn, alpha;
        if (__builtin_expect(__all(pmax - m_reg <= THR_RAW), 1)) { mn = m_reg; alpha = 1.f; }
        else { mn = fmaxf(m_reg, pmax); alpha = __builtin_amdgcn_exp2f((m_reg - mn) * C); m_reg = mn; }
        const float mnC = (tbias - mn) * C;
#pragma unroll
        for (int r = 0; r < 16; ++r) { p0[r] = __builtin_amdgcn_exp2f(fmaf(p0[r], C, mnC)); p1[r] = __builtin_amdgcn_exp2f(fmaf(p1[r], C, mnC)); }
        float ps = 0.f;
#pragma unroll
        for (int r = 0; r < 16; ++r) ps += p0[r];
#pragma unroll
        for (int r = 0; r < 16; ++r) ps += p1[r];
        ps = pair_sum(ps);
        l_reg = l_reg * alpha + ps;
        if (__any(alpha < 1.f)) {
            if (hi == 0) al_l[r32] = alpha;
            asm volatile("s_waitcnt lgkmcnt(0)" ::: "memory");
#pragma unroll
            for (int r = 0; r < 16; ++r) { const float f = al_l[crow(r, hi)];
#pragma unroll
                for (int d = 0; d < 4; ++d) o[d][r] *= f; }
        }
        bf16x8 pa0, pa1, pa2, pa3;
        pack_p(p0, p1, pa0, pa1, pa2, pa3);
        pv_d0(o, vb0 + vs_ * L::VB, pa0, pa1, pa2, pa3);
    };
    int kt = pol.first_tile();
    bool wdone = false;
    int nk = pol.next_tile(kt);
    if constexpr (!P::SKEW) {
        FA_DMA(kt, 0, 0);
        if constexpr (RING == 3) { if (nk >= 0) { FA_DMA(nk, 1, 1); FA_WAITV_NI(); } else FA_WAITV0(); } else FA_WAITV0();
        FA_LBAR();
        int cur = 0;
        for (int it = 0;; ++it) {
            int nk2 = -1;
            if constexpr (RING == 3) { nk2 = nk >= 0 ? pol.next_tile(nk) : -1; if (nk2 >= 0) FA_DMA(nk2, (cur == 0 ? 2 : cur - 1), (cur == 0 ? 2 : cur - 1)); }
            else { if (nk >= 0) FA_DMA(nk, cur ^ 1, cur ^ 1); }
            if (!wdone && !pol.wave_skip(kt)) { qk(kt, cur); smpv(cur); }
            const int par = it & 1;
            if constexpr (P::STOP) {
                if (nk >= 0) { if (!wdone) wdone = pol.wave_done(nk, m_reg); if (lane == 0) *(volatile LAS int*)(flags + par * 8 + wid) = wdone ? 1 : 0; }
            }
            if (nk >= 0) { if (RING == 3 && nk2 >= 0) FA_WAITV_NI(); else FA_WAITV0(); }
            FA_LBAR();
            if (nk < 0) break;
            if constexpr (P::STOP) { if (FA_ALLDONE(par)) break; }
            kt = nk;
            if constexpr (RING == 3) { nk = nk2; cur = (cur == 2 ? 0 : cur + 1); } else { nk = pol.next_tile(kt); cur ^= 1; }
        }
        if constexpr (P::STOP) { FA_WAITV0(); FA_LBAR(); }
    } else {
        const bool h1 = widu >= 4;
        if (!h1) FA_DMA(kt, 0, 0);
        FA_WAITV0(); FA_LBAR();
        int cur = 0, vcur = 0;
        if (!h1) {
            for (int it = 0;; ++it) {
                const int vnx = vcur == 2 ? 0 : vcur + 1, par = it & 1;
                if (nk >= 0) FA_DMA(nk, cur ^ 1, vnx);
                if (!wdone && !pol.wave_skip(kt)) { qk(kt, cur); smpv(vcur); }
                if constexpr (P::STOP) { if (nk >= 0) { if (!wdone) wdone = pol.wave_done(nk, m_reg); if (lane == 0) *(volatile LAS int*)(flags + par * 8 + wid) = wdone ? 1 : 0; } }
                FA_WAITV0(); FA_LBAR();
                if (nk < 0) break;
                if constexpr (P::STOP) { if (FA_ALLDONE(par)) break; }
                kt = nk; nk = pol.next_tile(kt); cur ^= 1; vcur = vnx;
            }
        } else {
            bool pend = false; int vprev = 0;
            for (int it = 0;; ++it) {
                const int vnx = vcur == 2 ? 0 : vcur + 1, par = it & 1;
                if (pend) smpv(vprev);
                if constexpr (P::STOP) { if (!wdone) wdone = pol.wave_done(kt, m_reg); if (lane == 0) *(volatile LAS int*)(flags + par * 8 + wid) = wdone ? 1 : 0; }
                pend = !wdone && !pol.wave_skip(kt);
                if (pend) qk(kt, cur);
                vprev = vcur;
                FA_WAITV0(); FA_LBAR();
                if (nk < 0) break;
                if constexpr (P::STOP) { if (FA_ALLDONE(par)) break; }
                kt = nk; nk = pol.next_tile(kt); cur ^= 1; vcur = vnx;
            }
            if (pend) smpv(vprev);
        }
        FA_WAITV0(); FA_LBAR();
    }
    if (kt_last) *kt_last = kt;
#undef FA_DMA
#undef FA_WAITV_NI
#undef FA_WAITV0
#undef FA_LBAR
#undef FA_ALLDONE
}
__device__ __forceinline__ void row_inv_l(unsigned char* lds_ws, float l_reg, float (&rli)[16]) {
    const int tid = threadIdx.x, wid = tid >> 6, lane = tid & 63, r32 = lane & 31, hi = lane >> 5;
    float* li_l = (float*)lds_ws + wid * 64;
    if (hi == 0) li_l[r32] = l_reg;
    asm volatile("s_waitcnt lgkmcnt(0)" ::: "memory");
#pragma unroll
    for (int r = 0; r < 16; ++r) { const float l = li_l[crow(r, hi)]; rli[r] = l > 0.f ? __builtin_amdgcn_rcpf(l) : 0.f; }
}
__device__ __forceinline__ void row_factor(unsigned char* lds_ws, float f, float (&fr)[16]) {
    const int tid = threadIdx.x, wid = tid >> 6, lane = tid & 63, r32 = lane & 31, hi = lane >> 5;
    float* li_l = (float*)lds_ws + wid * 64;
    if (hi == 0) li_l[r32] = f;
    asm volatile("s_waitcnt lgkmcnt(0)" ::: "memory");
#pragma unroll
    for (int r = 0; r < 16; ++r) fr[r] = li_l[crow(r, hi)];
    asm volatile("s_waitcnt lgkmcnt(0)" ::: "memory");
}
template <int DK> __device__ __forceinline__ void load_q(const bf16_t* qrow, int hi, bf16x8 (&qr)[DK / 16]) {
#pragma unroll
    for (int d0 = 0; d0 < DK / 16; ++d0) qr[d0] = *(const bf16x8*)(qrow + d0 * 16 + hi * 8);
}

__device__ __forceinline__ void norm_q128(bf16x8 (&qr)[8], const float* __restrict__ g, int hi) {
    float ss = 0.f;
#pragma unroll
    for (int d0 = 0; d0 < 8; ++d0)
#pragma unroll
        for (int e = 0; e < 8; ++e) { const float f = __uint_as_float(((unsigned)(unsigned short)qr[d0][e]) << 16); ss += f * f; }
    ss = pair_sum(ss);
    const float r = rsqrtf(ss * (1.f / 128.f) + 1e-6f);
#pragma unroll
    for (int d0 = 0; d0 < 8; ++d0) { const f32x4 g0 = *(const f32x4*)(g + d0 * 16 + hi * 8), g1 = *(const f32x4*)(g + d0 * 16 + hi * 8 + 4);
        float f[8];
#pragma unroll
        for (int e = 0; e < 8; ++e) f[e] = __uint_as_float(((unsigned)(unsigned short)qr[d0][e]) << 16) * r;
        u32x4 w; w.x = cvtpk(f[0] * g0[0], f[1] * g0[1]); w.y = cvtpk(f[2] * g0[2], f[3] * g0[3]); w.z = cvtpk(f[4] * g1[0], f[5] * g1[1]); w.w = cvtpk(f[6] * g1[2], f[7] * g1[3]);
        qr[d0] = *reinterpret_cast<bf16x8*>(&w); }
}
__device__ __forceinline__ float bfv(short v) { return __uint_as_float(((unsigned)(unsigned short)v) << 16); }
__device__ __forceinline__ void norm_q_mla(bf16x8 (&qr)[12], const float* __restrict__ qn, const float* __restrict__ rope, int tok, int hi) {
    float ssn = 0.f, ssr = 0.f;
#pragma unroll
    for (int d0 = 0; d0 < 8; ++d0)
#pragma unroll
        for (int e = 0; e < 8; ++e) { const float f = bfv(qr[d0][e]); ssn += f * f; }
#pragma unroll
    for (int d0 = 8; d0 < 12; ++d0)
#pragma unroll
        for (int e = 0; e < 8; ++e) { const float f = bfv(qr[d0][e]); ssr += f * f; }
    ssn = pair_sum(ssn); ssr = pair_sum(ssr);
    const float rn = rsqrtf(ssn * (1.f / 128.f) + 1e-6f), rr = rsqrtf(ssr * (1.f / 64.f) + 1e-6f);
#pragma unroll
    for (int d0 = 0; d0 < 8; ++d0) { const f32x4 g0 = *(const f32x4*)(qn + d0 * 16 + hi * 8), g1 = *(const f32x4*)(qn + d0 * 16 + hi * 8 + 4);
        u32x4 w; w.x = cvtpk(bfv(qr[d0][0]) * rn * g0[0], bfv(qr[d0][1]) * rn * g0[1]); w.y = cvtpk(bfv(qr[d0][2]) * rn * g0[2], bfv(qr[d0][3]) * rn * g0[3]);
        w.z = cvtpk(bfv(qr[d0][4]) * rn * g1[0], bfv(qr[d0][5]) * rn * g1[1]); w.w = cvtpk(bfv(qr[d0][6]) * rn * g1[2], bfv(qr[d0][7]) * rn * g1[3]);
        qr[d0] = *reinterpret_cast<bf16x8*>(&w); }
#pragma unroll
    for (int b = 0; b < 2; ++b) {
        const int i0 = b * 16 + hi * 8;
        float x1[8], x2[8];
#pragma unroll
        for (int e = 0; e < 8; ++e) { x1[e] = bfv(qr[8 + b][e]) * rr * qn[128 + i0 + e]; x2[e] = bfv(qr[10 + b][e]) * rr * qn[160 + i0 + e]; }
        const float* cs = rope + ((size_t)tok * 32 + i0) * 2;
        float o1[8], o2[8];
#pragma unroll
        for (int e = 0; e < 8; ++e) { const float c = cs[2 * e], s = cs[2 * e + 1]; o1[e] = x1[e] * c - x2[e] * s; o2[e] = x1[e] * s + x2[e] * c; }
        u32x4 w1, w2; w1.x = cvtpk(o1[0], o1[1]); w1.y = cvtpk(o1[2], o1[3]); w1.z = cvtpk(o1[4], o1[5]); w1.w = cvtpk(o1[6], o1[7]);
        w2.x = cvtpk(o2[0], o2[1]); w2.y = cvtpk(o2[2], o2[3]); w2.z = cvtpk(o2[4], o2[5]); w2.w = cvtpk(o2[6], o2[7]);
        qr[8 + b] = *reinterpret_cast<bf16x8*>(&w1); qr[10 + b] = *reinterpret_cast<bf16x8*>(&w2);
    }
}
struct AugC { short chi, clo; };
__device__ __forceinline__ AugC aug_split(float c) { const bf16_t h = f2bf(c); const bf16_t l = f2bf(c - bf2f(h)); return AugC{(short)h, (short)l}; }
__device__ __forceinline__ bf16x8 aug_q(AugC c, bool masked, int hi) { bf16x8 q = {}; if (hi == 0) { q[0] = c.chi; q[1] = c.clo; q[2] = masked ? (short)0xFF80 : (short)0; } return q; }

struct MlaPol {
    static constexpr int DK = 192; static constexpr float SCALE = 0.07216878364870322f; static constexpr bool AUG = false, STOP = false, SKEW = true; static constexpr int RING = 3;
    const bf16_t* KVU; const bf16_t* KR; int h; int t0w; int qpos; int kt_hi;
    __device__ __forceinline__ int first_tile() const { return 0; }
    __device__ __forceinline__ int next_tile(int kt) const { return kt < kt_hi ? kt + 1 : -1; }
    __device__ __forceinline__ const bf16_t* kptr(int key, int c) const { return c < 16 ? KVU + (size_t)key * 4096 + h * 256 + c * 8 : KR + (size_t)key * 64 + (c - 16) * 8; }
    __device__ __forceinline__ const bf16_t* vptr(int key, int c) const { return KVU + (size_t)key * 4096 + h * 256 + 128 + c * 8; }
    __device__ __forceinline__ bool wave_skip(int kt) const { return kt * 64 > t0w + 31; }
    __device__ __forceinline__ bool need_mask(int kt) const { return kt * 64 + 63 > t0w; }
    __device__ __forceinline__ unsigned tile_state(int) const { return 0u; }
    __device__ __forceinline__ float score(float s, int kpos, unsigned) const { return kpos <= qpos ? s : -INFINITY; }
};
__device__ __forceinline__ void mla_attn_phase(unsigned char* lds, const bf16_t* QU, const bf16_t* KVU, const bf16_t* KR, const bf16_t* PB, const float* qn, const float* rope, bf16_t* AO, unsigned* qctr) {
    const int tid = threadIdx.x, wid = tid >> 6, lane = tid & 63, r32 = lane & 31, hi = lane >> 5;
    const int bx = blockIdx.x;
    const int h = (bx & 7) * 2 + ((bx >> 3) >> 4), j = (bx >> 3) & 15;
    for (int uu = 0; uu < 2; ++uu) {
        int qb = 31 - j;
        if (uu == 1) { volatile LAS int* qslot = (volatile LAS int*)(lds + 163000);
            if (tid == 0) *qslot = (int)__hip_atomic_fetch_add(qctr + h, 1u, __ATOMIC_RELAXED, __HIP_MEMORY_SCOPE_AGENT);
            __syncthreads(); qb = 15 - (*qslot & 15); }
        const int t0w = qb * 256 + wid * 32;
        MlaPol pol{KVU, KR, h, t0w, t0w + r32, qb * 4 + 3};
        bf16x8 qr[12];
        load_q<192>(QU + (size_t)(t0w + r32) * 3072 + h * 192, hi, qr);
        norm_q_mla(qr, qn, rope, t0w + r32, hi);
        f32x16 o[4] = {}; float m_reg = -1e30f, l_reg = 0.f;
        flash_pass<MlaPol>(pol, lds, qr, o, m_reg, l_reg);
        float rli[16];
        row_inv_l(lds + PolLds<MlaPol>::WS0, l_reg, rli);
#pragma unroll
        for (int r = 0; r < 16; ++r) { const int tok = t0w + crow(r, hi);
            const bf16_t* g = PB + (size_t)tok * 3072 + 832 + h * 128; bf16_t* ao = AO + (size_t)tok * DM + h * 128;
#pragma unroll
            for (int d0 = 0; d0 < 4; ++d0) { const int col = d0 * 32 + r32; ao[col] = f2bf(o[d0][r] * rli[r] * silu_f(bf2f(g[col]))); } }
        __syncthreads();
    }
}

struct MobaPol {
    static constexpr int DK = 128; static constexpr float SCALE = 0.08838834764831845f; static constexpr bool AUG = true, STOP = true, SKEW = true; static constexpr int RING = 3;
    const bf16_t* PB; int h; int own; int t0w; int qpos; unsigned mask; float craw; AugC cc; float qkmax; int kt_first, kt_last; float m_lb;
    __device__ __forceinline__ int first_tile() const { return kt_first; }
    __device__ __forceinline__ int next_tile(int kt) const { return kt > kt_last ? kt - 1 : -1; }
    __device__ __forceinline__ const bf16_t* kptr(int key, int c) const { return PB + (size_t)key * 8192 + 2048 + h * 128 + c * 8; }
    __device__ __forceinline__ const bf16_t* vptr(int key, int c) const { return PB + (size_t)key * 8192 + 4096 + h * 128 + c * 8; }
    __device__ __forceinline__ bool wave_skip(int kt) const { const int b = kt >> 2; return b == own ? (kt * 64 > t0w + 31) : !__any((int)((mask >> b) & 1u)); }
    __device__ __forceinline__ bf16x8 qaug(int kt, int hi) const { return aug_q(cc, !((mask >> (kt >> 2)) & 1u), hi); }
    __device__ __forceinline__ float tile_bias(int kt) const { return craw * (float)(kt * 64 - own * 256); }
    __device__ __forceinline__ bool wave_done(int nk, float m) const { return __all((qkmax + craw * (float)(nk * 64 + 63 - own * 256) - fmaxf(m, m_lb)) * (SCALE * LOG2E) < -152.f); }
    __device__ __forceinline__ bool need_mask(int kt) const { return kt * 64 + 63 > t0w; }
    __device__ __forceinline__ unsigned tile_state(int) const { return 0u; }
    __device__ __forceinline__ float score(float s, int kpos, unsigned) const { return kpos <= qpos ? s : -INFINITY; }
};
__device__ __forceinline__ float max_abs128(const float* g, int lane) { float v = fmaxf(fabsf(g[lane]), fabsf(g[lane + 64])); return wave_max(v); }
__device__ __forceinline__ float bflo(short v) { return __uint_as_float(((unsigned)(unsigned short)v) << 16); }

constexpr int MOBA_UPH = 16 + 16 * 2, MOBA_NSPLIT = 10 * MOBA_UPH, MOBA_NUNITS = MOBA_NSPLIT + 6 * 32;
__device__ __forceinline__ void moba_unit(int ui, int& h, int& qb, int& part) {
    if (ui < MOBA_NSPLIT) { h = 15 - ui / MOBA_UPH; const int e = ui % MOBA_UPH; qb = e < 32 ? 31 - (e >> 1) : 47 - e; part = e < 32 ? (e & 1) : -1; }
    else { const int v = ui - MOBA_NSPLIT; h = 5 - (v >> 5); qb = 31 - (v & 31); part = -1; }
}
__device__ __forceinline__ int moba_est(int ui) {
    int h, qb, part; moba_unit(ui, h, qb, part);
    const int cut = (int)(115.f / (alibi_slope(h) * 64.f)) + 2;
    if (part < 0) { const int T = 4 * qb + 4; return T < cut ? T : cut; }
    const int T = 2 * qb + 2;
    if (part == 0) return T < cut ? T : cut;
    return cut > T ? (T < cut - T ? T : cut - T) : 1;
}
__device__ __forceinline__ int moba_sub(int ui) { int h, qb, part; moba_unit(ui, h, qb, part); return h >= 8 ? 15 - h : h; }
__device__ __forceinline__ int moba_sub_count(int x) { return 48 + (x >= 6 ? 48 : 32); }
__device__ __forceinline__ void moba_order_phase(int* order) {
    const int wid = threadIdx.x >> 6, lane = threadIdx.x & 63;
    for (int u = blockIdx.x * 8 + wid; u < MOBA_NUNITS; u += gridDim.x * 8) {
        const int eu = moba_est(u), xu = moba_sub(u); int cnt = 0;
        for (int v = lane; v < MOBA_NUNITS; v += 64) { const int ev = moba_est(v); cnt += (moba_sub(v) == xu && (ev > eu || (ev == eu && v < u))) ? 1 : 0; }
        for (int o = 32; o > 0; o >>= 1) cnt += __shfl_xor(cnt, o);
        if (lane == 0) order[xu * 96 + cnt] = u;
    }
}
__device__ __forceinline__ void moba_attn_phase(unsigned char* lds, const bf16_t* PB, const float* KPART, const float* qn, const float* kn, unsigned* ctr, unsigned* split,
                                                unsigned char* scratch, const int* order, bf16_t* AO) {
    const int tid = threadIdx.x, wid = tid >> 6, lane = tid & 63, r32 = lane & 31, hi = lane >> 5;
    const float qkmax = 128.f * 1.02f * max_abs128(qn, lane) * max_abs128(kn, lane);
    float* kml = (float*)(lds + PolLds<MobaPol>::TOTAL + 128);
    volatile LAS int* slot = (volatile LAS int*)(lds + PolLds<MobaPol>::TOTAL + 64);
    int hprev = -1;
    const int xq = (int)blockIdx.x & 7;
    for (;;) {
        if (tid == 0) *slot = (int)__hip_atomic_fetch_add(ctr + xq * 8, 1u, __ATOMIC_RELAXED, __HIP_MEMORY_SCOPE_AGENT);
        __syncthreads();
        const int ti = *slot;
        if (ti >= moba_sub_count(xq)) break;
        int h, qb, part;
        moba_unit(order[xq * 96 + ti], h, qb, part);
        const float slope = alibi_slope(h);
        if (h != hprev) {
            for (int idx = tid; idx < 32 * 128; idx += 512) { const int n = idx >> 7, d = idx & 127; float s = 0.f;
#pragma unroll
                for (int i = 0; i < 8; ++i) s += KPART[(size_t)(8 * n + i) * 2048 + h * 128 + d];
                kml[idx] = s * (1.f / 256.f); }
            hprev = h;
            __syncthreads();
        }
        const int t0w = qb * 256 + wid * 32;
        bf16x8 qr[8];
        load_q<128>(PB + (size_t)(t0w + r32) * 8192 + h * 128, hi, qr);
        norm_q128(qr, qn, hi);
        float b0 = -INFINITY, b1 = -INFINITY, b2 = -INFINITY; int i0 = 0, i1 = 0, i2 = 0;
        for (int n = 0; n < qb; ++n) {
            const float* km = kml + n * 128 + hi * 8;
            float s = 0.f;
#pragma unroll
            for (int d0 = 0; d0 < 8; ++d0) { const f32x4 ka = *(const f32x4*)(km + d0 * 16), kb = *(const f32x4*)(km + d0 * 16 + 4);
                s += bflo(qr[d0][0]) * ka[0] + bflo(qr[d0][1]) * ka[1] + bflo(qr[d0][2]) * ka[2] + bflo(qr[d0][3]) * ka[3];
                s += bflo(qr[d0][4]) * kb[0] + bflo(qr[d0][5]) * kb[1] + bflo(qr[d0][6]) * kb[2] + bflo(qr[d0][7]) * kb[3]; }
            s = pair_sum(s);
            if (s > b0) { b2 = b1; i2 = i1; b1 = b0; i1 = i0; b0 = s; i0 = n; }
            else if (s > b1) { b2 = b1; i2 = i1; b1 = s; i1 = n; }
            else if (s > b2) { b2 = s; i2 = n; }
        }
        unsigned mask = 1u << qb;
        if (b0 > -INFINITY) mask |= 1u << i0;
        if (b1 > -INFINITY) mask |= 1u << i1;
        if (b2 > -INFINITY) mask |= 1u << i2;
        const float craw = slope / MobaPol::SCALE;
        const int kt_first = part == 1 ? 2 * qb + 1 : 4 * qb + 3, kt_last = part == 0 ? 2 * qb + 2 : 0;
        MobaPol pol{PB, h, qb, t0w, t0w + r32, mask, craw, aug_split(craw), qkmax, kt_first, kt_last, -qkmax + craw * (float)(t0w + r32 - qb * 256)};
        f32x16 o[4] = {}; float m_reg = -1e30f, l_reg = 0.f;
        flash_pass<MobaPol>(pol, lds, qr, o, m_reg, l_reg);
        bool write_out = true;
        if (part >= 0) {
            unsigned char* sb = scratch + ((size_t)((h - 6) * 16 + (qb - 16)) * 2 + part) * (size_t)(65536 + 4096);
            u32x4* so = (u32x4*)sb + (wid * 8) * 64 + lane;
#pragma unroll
            for (int d0 = 0; d0 < 4; ++d0)
#pragma unroll
                for (int q4 = 0; q4 < 2; ++q4) { u32x4 w; w.x = cvtpk(o[d0][q4 * 8 + 0], o[d0][q4 * 8 + 1]); w.y = cvtpk(o[d0][q4 * 8 + 2], o[d0][q4 * 8 + 3]);
                    w.z = cvtpk(o[d0][q4 * 8 + 4], o[d0][q4 * 8 + 5]); w.w = cvtpk(o[d0][q4 * 8 + 6], o[d0][q4 * 8 + 7]); so[(d0 * 2 + q4) * 64] = w; }
            ((float2*)(sb + 65536))[wid * 64 + lane] = make_float2(m_reg, l_reg);
            asm volatile("s_waitcnt vmcnt(0)" ::: "memory");
            __syncthreads();
            if (tid == 0) {
                __builtin_amdgcn_fence(__ATOMIC_RELEASE, "agent");
                asm volatile("s_waitcnt vmcnt(0)" ::: "memory");
                const unsigned old = __hip_atomic_fetch_add(split + h * 32 + qb, 1u, __ATOMIC_RELAXED, __HIP_MEMORY_SCOPE_AGENT);
                __builtin_amdgcn_fence(__ATOMIC_ACQUIRE, "agent");
                asm volatile("s_waitcnt vmcnt(0)" ::: "memory");
                *slot = (int)old;
            }
            __syncthreads();
            write_out = (*slot != 0);
            if (write_out) {
                const unsigned char* pb = scratch + ((size_t)((h - 6) * 16 + (qb - 16)) * 2 + (1 - part)) * (size_t)(65536 + 4096);
                const float2 ml = ((const float2*)(pb + 65536))[wid * 64 + lane];
                constexpr float C = MobaPol::SCALE * LOG2E;
                const float mN = part == 0 ? m_reg : ml.x, mF = part == 0 ? ml.x : m_reg, lN = part == 0 ? l_reg : ml.y, lF = part == 0 ? ml.y : l_reg;
                const float M = fmaxf(mN, mF);
                const float fN = __builtin_amdgcn_exp2f((mN - M) * C), fF = __builtin_amdgcn_exp2f((mF - M) * C);
                l_reg = __fadd_rn(__fmul_rn(lN, fN), __fmul_rn(lF, fF));
                float FN[16], FF[16];
                row_factor(lds + PolLds<MobaPol>::WS0, fN, FN);
                row_factor(lds + PolLds<MobaPol>::WS0, fF, FF);
                const u32x4* po = (const u32x4*)pb + (wid * 8) * 64 + lane;
                const u32x4* pown = (const u32x4*)sb + (wid * 8) * 64 + lane;
#pragma unroll
                for (int d0 = 0; d0 < 4; ++d0)
#pragma unroll
                    for (int q4 = 0; q4 < 2; ++q4) { const u32x4 w = po[(d0 * 2 + q4) * 64]; const unsigned ww[4] = {w.x, w.y, w.z, w.w};
                        const u32x4 wo = pown[(d0 * 2 + q4) * 64]; const unsigned wwo[4] = {wo.x, wo.y, wo.z, wo.w};
#pragma unroll
                        for (int e2 = 0; e2 < 4; ++e2) { const int r = q4 * 8 + e2 * 2;
                            const float own0 = __uint_as_float(wwo[e2] << 16), own1 = __uint_as_float(wwo[e2] & 0xffff0000u);
                            const float oth0 = __uint_as_float(ww[e2] << 16), oth1 = __uint_as_float(ww[e2] & 0xffff0000u);
                            const float n0 = part == 0 ? own0 : oth0, f0 = part == 0 ? oth0 : own0, n1 = part == 0 ? own1 : oth1, f1 = part == 0 ? oth1 : own1;
                            o[d0][r] = __fadd_rn(__fmul_rn(n0, FN[r]), __fmul_rn(f0, FF[r]));
                            o[d0][r + 1] = __fadd_rn(__fmul_rn(n1, FN[r + 1]), __fmul_rn(f1, FF[r + 1])); } }
            }
        }
        if (write_out) {
            float rli[16];
            row_inv_l(lds + PolLds<MobaPol>::WS0, l_reg, rli);
#pragma unroll
            for (int r = 0; r < 16; ++r) { const int tok = t0w + crow(r, hi);
                const bf16_t* g = PB + (size_t)tok * 8192 + 6144 + h * 128; bf16_t* ao = AO + (size_t)tok * DM + h * 128;
#pragma unroll
                for (int d0 = 0; d0 < 4; ++d0) { const int col = d0 * 32 + r32; ao[col] = f2bf(o[d0][r] * rli[r] * silu_f(bf2f(g[col]))); } }
        }
        __syncthreads();
    }
}

__device__ __forceinline__ float pair_other(float v, int hi) { auto rr = __builtin_amdgcn_permlane32_swap(__float_as_uint(v), __float_as_uint(v), false, false); return __uint_as_float(hi ? rr[0] : rr[1]); }

__device__ __forceinline__ void sb_half(f32x16& p, int kpos0, bool diag, int qpos, int hi, float& run) {
    constexpr float SCALE = 0.08838834764831845f;
    f32x16 om;
#pragma unroll
    for (int r = 0; r < 16; ++r) { const float z = p[r] * SCALE; const float e = __builtin_amdgcn_exp2f(-fabsf(z) * LOG2E); const float rr = __builtin_amdgcn_rcpf(1.f + e), er = e * rr;
        p[r] = z >= 0.f ? rr : er; om[r] = z >= 0.f ? er : rr; }
    if (diag) {
#pragma unroll
        for (int r = 0; r < 16; ++r) if (kpos0 + crow(r, hi) >= qpos) { om[r] = 1.f; p[r] = 0.f; }
    }
#pragma unroll
    for (int k = 0; k < 4; ++k) { om[4 * k + 2] *= om[4 * k + 3]; om[4 * k + 1] *= om[4 * k + 2]; om[4 * k] *= om[4 * k + 1]; }
#pragma unroll
    for (int k = 3; k >= 0; --k) {
        const float tm = om[4 * k], to = pair_other(tm, hi);
        const float sk = hi == 0 ? run * to : run; run *= tm * to;
        p[4 * k + 3] *= sk; p[4 * k + 2] *= sk * om[4 * k + 3]; p[4 * k + 1] *= sk * om[4 * k + 2]; p[4 * k] *= sk * om[4 * k + 1];
    }
}
__device__ __forceinline__ void sb_attn_phase(unsigned char* lds, const bf16_t* PB, bf16_t* AO, unsigned* qctr) {
    constexpr int SLOT = 32768, KBY = 16384;
    int tid = threadIdx.x; asm volatile("" : "+v"(tid));
    const int wid = tid >> 6, lane = tid & 63, r32 = lane & 31, hi = lane >> 5;
    const int bx = blockIdx.x;
    const int h = (bx & 7) * 2 + ((bx >> 3) >> 4), j = (bx >> 3) & 15;
    volatile LAS int* flags = (volatile LAS int*)(lds + 4 * SLOT);
    const int sr = tid >> 4, sc = tid & 15;
    const int vst0 = v_st(sr, sc * 8), vst1 = v_st(32 + sr, sc * 8);
    const int vbl = (int)(uintptr_t)lds + KBY + v_rd_base(lane);
    const bf16_t* kbase = PB + 2048 + h * 128 + sc * 8; const bf16_t* vbase = PB + 4096 + h * 128 + sc * 8;
    for (int uu = 0; uu < 2; ++uu) {
        int qb = 31 - j;
        if (uu == 1) { volatile LAS int* qslot = (volatile LAS int*)(lds + 163000);
            if (tid == 0) *qslot = (int)__hip_atomic_fetch_add(qctr + h, 1u, __ATOMIC_RELAXED, __HIP_MEMORY_SCOPE_AGENT);
            __syncthreads(); qb = 15 - (*qslot & 15); }
        const int t0w = qb * 256 + wid * 32, qpos = t0w + r32;
        bf16x8 qr[8];
        load_q<128>(PB + (size_t)qpos * 8192 + h * 128, hi, qr);
        f32x16 o[4] = {}; float carry = 1.f; bool done = false;
        const int T = qb * 4, my_top = (t0w + 30) >> 6;
        u32x4 sk0, sk1, sv0, sv1, tk0, tk1, tv0, tv1;
#define SB_SLOAD(kt, K0, K1, V0, V1) do { const size_t kb_ = (size_t)(kt) * 64; K0 = *(const u32x4*)(kbase + (kb_ + sr) * 8192); K1 = *(const u32x4*)(kbase + (kb_ + 32 + sr) * 8192); \
        V0 = *(const u32x4*)(vbase + (kb_ + sr) * 8192); V1 = *(const u32x4*)(vbase + (kb_ + 32 + sr) * 8192); } while (0)
#define SB_SWRITE(kt, K0, K1, V0, V1) do { unsigned char* sl_ = lds + ((kt) & 3) * SLOT; *(u32x4*)(sl_ + kswz<128>(sr, sc * 16)) = K0; *(u32x4*)(sl_ + kswz<128>(32 + sr, sc * 16)) = K1; \
        *(u32x4*)(sl_ + KBY + vst0) = V0; *(u32x4*)(sl_ + KBY + vst1) = V1; } while (0)
        SB_SLOAD(T + 3, sk0, sk1, sv0, sv1); SB_SLOAD(T + 2, tk0, tk1, tv0, tv1);
        SB_SWRITE(T + 3, sk0, sk1, sv0, sv1); SB_SWRITE(T + 2, tk0, tk1, tv0, tv1);
        SB_SLOAD(T + 1, sk0, sk1, sv0, sv1); SB_SLOAD(T, tk0, tk1, tv0, tv1);
        SB_SWRITE(T + 1, sk0, sk1, sv0, sv1); SB_SWRITE(T, tk0, tk1, tv0, tv1);
        __syncthreads();
        for (int s = 0;; ++s) {
            const int tin = T - s - 1, kt = my_top - s;
            if (tin >= 0) SB_SLOAD(tin, sk0, sk1, sv0, sv1);
            if (!done && kt >= 0) {
                const unsigned char* Kc = lds + (kt & 3) * SLOT;
                const int kb = kt * 64;
                const bool diag = kb + 63 >= t0w;
                float run = carry;
                f32x16 p1 = {};
#pragma unroll
                for (int d0 = 0; d0 < 8; ++d0) p1 = __builtin_amdgcn_mfma_f32_32x32x16_bf16(*(const bf16x8*)(Kc + kswz<128>(32 + r32, d0 * 32 + hi * 16)), qr[d0], p1, 0, 0, 0);
                sb_half(p1, kb + 32, diag, qpos, hi, run);
                f32x16 p0 = {};
#pragma unroll
                for (int d0 = 0; d0 < 8; ++d0) p0 = __builtin_amdgcn_mfma_f32_32x32x16_bf16(*(const bf16x8*)(Kc + kswz<128>(r32, d0 * 32 + hi * 16)), qr[d0], p0, 0, 0, 0);
                sb_half(p0, kb, diag, qpos, hi, run);
                carry = run;
                bf16x8 pa0, pa1, pa2, pa3;
                pack_p(p0, p1, pa0, pa1, pa2, pa3);
                pv_d0(o, vbl + (kt & 3) * SLOT, pa0, pa1, pa2, pa3);
                done = __all(carry == 0.f);
            }
            if (lane == 0) flags[(s & 1) * 8 + wid] = (done || kt <= 0) ? 1 : 0;
            __syncthreads();
            int alld = 1;
#pragma unroll
            for (int w = 0; w < 8; ++w) alld &= flags[(s & 1) * 8 + w];
            if (alld) break;
            if (tin >= 0) SB_SWRITE(tin, sk0, sk1, sv0, sv1);
            __syncthreads();
        }
#undef SB_SLOAD
#undef SB_SWRITE
#pragma unroll
        for (int r = 0; r < 16; ++r) { const int tok = t0w + crow(r, hi);
            const bf16_t* g = PB + (size_t)tok * 8192 + 6144 + h * 128; bf16_t* ao = AO + (size_t)tok * DM + h * 128;
#pragma unroll
            for (int d0 = 0; d0 < 4; ++d0) { const int col = d0 * 32 + r32; ao[col] = f2bf(o[d0][r] * silu_f(bf2f(g[col]))); } }
        __syncthreads();
    }
}

using NsaLds = LdsMap<128, 2, 2>;
constexpr int NSA_IMP = NsaLds::TOTAL + 128;
constexpr int NSA_COMB = NSA_IMP;
constexpr int NSA_SELM = NSA_COMB + 8 * 32 * 64 * 4;
static_assert(NSA_SELM + 1024 <= 163840 - 16, "NSA LDS map");
struct NsaCmpPol {
    static constexpr int DK = 128; static constexpr float SCALE = 0.08838834764831845f; static constexpr bool AUG = false, STOP = true, SKEW = false; static constexpr int RING = 2;
    const bf16_t* KC; const bf16_t* VC; int kt_hi; int tmaxw; int qpos; float nslope; float qkmax;
    __device__ __forceinline__ const bf16_t* kptr(int key, int c) const { return KC + (size_t)key * 128 + c * 8; }
    __device__ __forceinline__ const bf16_t* vptr(int key, int c) const { return VC + (size_t)key * 128 + c * 8; }
    __device__ __forceinline__ int first_tile() const { return kt_hi; }
    __device__ __forceinline__ int next_tile(int kt) const { return kt - 1; }
    __device__ __forceinline__ bool wave_skip(int kt) const { return 16 * (64 * kt) + 31 > tmaxw; }
    __device__ __forceinline__ bool wave_done(int nk, float m) const { return __all((qkmax + nslope * (float)(qpos - (16 * (64 * nk + 63) + 31)) - m) * (SCALE * LOG2E) < -152.f); }
    __device__ __forceinline__ bool need_mask(int) const { return true; }
    __device__ __forceinline__ unsigned tile_state(int) const { return 0u; }
    __device__ __forceinline__ float score(float s, int n, unsigned) const { const int ce = 16 * n + 31; return ce <= qpos ? fmaf(nslope, (float)(qpos - ce), s) : -INFINITY; }
};
__device__ __forceinline__ unsigned pick_word(int b, unsigned w0, unsigned w1, unsigned w2, unsigned w3) { return b < 64 ? (b < 32 ? w0 : w1) : (b < 96 ? w2 : w3); }
struct NsaSelPol {
    static constexpr int DK = 128; static constexpr float SCALE = 0.08838834764831845f; static constexpr bool AUG = true, STOP = true, SKEW = false; static constexpr int RING = 2;
    const bf16_t* PB; int g; int tb; int qpos; float craw; AugC cc; float qkmax; const unsigned* mrow; unsigned u0, u1, u2, u3;
    __device__ __forceinline__ const bf16_t* kptr(int key, int c) const { return PB + (size_t)key * LD3 + 3072 + g * 128 + c * 8; }
    __device__ __forceinline__ const bf16_t* vptr(int key, int c) const { return PB + (size_t)key * LD3 + 3584 + g * 128 + c * 8; }
    __device__ __forceinline__ int first_tile() const { return tb; }
    __device__ __forceinline__ int next_tile(int kt) const { for (int b = kt - 1; b >= 0; --b) if ((pick_word(b, u0, u1, u2, u3) >> (b & 31)) & 1u) return b; return -1; }
    __device__ __forceinline__ unsigned tile_state(int kt) const { return (mrow[kt >> 5] >> (kt & 31)) & 1u; }
    __device__ __forceinline__ bool wave_skip(int kt) const { return !__any((int)tile_state(kt)); }
    __device__ __forceinline__ bf16x8 qaug(int kt, int hi) const { return aug_q(cc, !tile_state(kt), hi); }
    __device__ __forceinline__ float tile_bias(int kt) const { return craw * (float)((kt - tb) * 64); }
    __device__ __forceinline__ bool wave_done(int nk, float m) const { return __all((qkmax + craw * (float)((nk - tb) * 64 + 63) - m) * (SCALE * LOG2E) < -152.f); }
    __device__ __forceinline__ bool need_mask(int kt) const { return kt == tb; }
    __device__ __forceinline__ float score(float s, int kpos, unsigned) const { return kpos <= qpos ? s : -INFINITY; }
};
struct NsaWinPol {
    static constexpr int DK = 128; static constexpr float SCALE = 0.08838834764831845f; static constexpr bool AUG = true, STOP = true, SKEW = false; static constexpr int RING = 2;
    const bf16_t* PB; int g; int tb; int qpos; float craw; AugC cc; float qkmax;
    __device__ __forceinline__ const bf16_t* kptr(int key, int c) const { return PB + (size_t)key * LD3 + 4096 + g * 128 + c * 8; }
    __device__ __forceinline__ const bf16_t* vptr(int key, int c) const { return PB + (size_t)key * LD3 + 4608 + g * 128 + c * 8; }
    __device__ __forceinline__ int first_tile() const { return tb; }
    __device__ __forceinline__ int next_tile(int kt) const { return (kt > 0 && kt > tb - 8) ? kt - 1 : -1; }
    __device__ __forceinline__ bool wave_skip(int) const { return false; }
    __device__ __forceinline__ bf16x8 qaug(int, int hi) const { return aug_q(cc, false, hi); }
    __device__ __forceinline__ float tile_bias(int kt) const { return craw * (float)((kt - tb) * 64); }
    __device__ __forceinline__ bool wave_done(int nk, float m) const { return __all((qkmax + craw * (float)((nk - tb) * 64 + 63) - m) * (SCALE * LOG2E) < -152.f); }
    __device__ __forceinline__ bool need_mask(int kt) const { return kt == tb || kt == tb - 8; }
    __device__ __forceinline__ unsigned tile_state(int) const { return 0u; }
    __device__ __forceinline__ float score(float s, int kpos, unsigned) const { const int d = qpos - kpos; return (d >= 0 && d < 512) ? s : -INFINITY; }
};
__device__ __forceinline__ void nsa_importance(const NsaCmpPol& pol, int kt_lo, unsigned char* lds, const bf16x8 (&qr)[8], float m_reg, float l_reg, float* impw) {
    using L = NsaLds;
    constexpr float C = NsaCmpPol::SCALE * LOG2E;
    int tid = threadIdx.x; asm volatile("" : "+v"(tid));
    const int lane = tid & 63, r32 = lane & 31, hi = lane >> 5;
    unsigned char* Kl = lds + L::K0;
    const int sr = tid >> 4, sc = tid & 15;
    bf16x8 cf[4];
#pragma unroll
    for (int ks = 0; ks < 4; ++ks)
#pragma unroll
        for (int jj = 0; jj < 8; ++jj) { const int nl = 16 * ks + 8 * hi + jj; cf[ks][jj] = (4 * r32 - 1 <= nl && nl <= 4 * r32 + 3) ? (short)0x3F80 : (short)0; }
    const float il = l_reg > 0.f ? __builtin_amdgcn_rcpf(l_reg) : 0.f, mnC = -m_reg * C;
    u32x4 sk0, sk1;
#define NI_SLOAD(kt) do { const int kb_ = (kt) * 64; sk0 = *(const u32x4*)pol.kptr(kb_ + sr, sc); sk1 = *(const u32x4*)pol.kptr(kb_ + 32 + sr, sc); } while (0)
#define NI_SWRITE(b) do { *(u32x4*)(Kl + (b) * L::KB + kswz<128>(sr, sc * 16)) = sk0; *(u32x4*)(Kl + (b) * L::KB + kswz<128>(32 + sr, sc * 16)) = sk1; } while (0)
    NI_SLOAD(pol.kt_hi); NI_SWRITE(0); __syncthreads();
    for (int kt = pol.kt_hi, it = 0; kt >= kt_lo; --kt, ++it) {
        const int cur = it & 1;
        if (kt > kt_lo) NI_SLOAD(kt - 1);
        if (!pol.wave_skip(kt)) {
            const unsigned char* Kc = Kl + cur * L::KB;
            f32x16 p0 = {}, p1 = {};
#pragma unroll
            for (int d0 = 0; d0 < 8; ++d0) { const int cb = d0 * 32 + hi * 16;
                const bf16x8 b0 = *(const bf16x8*)(Kc + kswz<128>(r32, cb));
                const bf16x8 b1 = *(const bf16x8*)(Kc + kswz<128>(32 + r32, cb));
                p0 = __builtin_amdgcn_mfma_f32_32x32x16_bf16(b0, qr[d0], p0, 0, 0, 0);
                p1 = __builtin_amdgcn_mfma_f32_32x32x16_bf16(b1, qr[d0], p1, 0, 0, 0); }
            const int kb = kt * 64;
#pragma unroll
            for (int r = 0; r < 16; ++r) {
                p0[r] = __builtin_amdgcn_exp2f(fmaf(pol.score(p0[r], kb + crow(r, hi), 0u), C, mnC)) * il;
                p1[r] = __builtin_amdgcn_exp2f(fmaf(pol.score(p1[r], kb + 32 + crow(r, hi), 0u), C, mnC)) * il; }
            bf16x8 pa0, pa1, pa2, pa3;
            pack_p(p0, p1, pa0, pa1, pa2, pa3);
            f32x16 acc = {};
            acc = __builtin_amdgcn_mfma_f32_32x32x16_bf16(pa0, cf[0], acc, 0, 0, 0);
            acc = __builtin_amdgcn_mfma_f32_32x32x16_bf16(pa1, cf[1], acc, 0, 0, 0);
            acc = __builtin_amdgcn_mfma_f32_32x32x16_bf16(pa2, cf[2], acc, 0, 0, 0);
            acc = __builtin_amdgcn_mfma_f32_32x32x16_bf16(pa3, cf[3], acc, 0, 0, 0);
            if (r32 <= 16) {
#pragma unroll
                for (int k = 0; k < 4; ++k) { float* q = impw + (2 * k + hi) * 160 + 16 * kt + r32; *q += (acc[4 * k] + acc[4 * k + 1]) + (acc[4 * k + 2] + acc[4 * k + 3]); }
            }
            asm volatile("s_waitcnt lgkmcnt(0)" ::: "memory");
        }
        if (kt > kt_lo) NI_SWRITE(cur ^ 1);
        __syncthreads();
    }
#undef NI_SLOAD
#undef NI_SWRITE
}
__device__ __forceinline__ unsigned wave_or(unsigned v) { for (int o = 32; o > 0; o >>= 1) v |= (unsigned)__shfl_xor((int)v, o); return v; }
template <int CTRL> __device__ __forceinline__ float dpp_f(float x) { return __int_as_float(__builtin_amdgcn_update_dpp(0, __float_as_int(x), CTRL, 0xF, 0xF, true)); }
template <int CTRL> __device__ __forceinline__ int dpp_i(int x) { return __builtin_amdgcn_update_dpp(0, x, CTRL, 0xF, 0xF, true); }
__device__ __forceinline__ float grp8_max(float x) { x = fmaxf(x, dpp_f<0xB1>(x)); x = fmaxf(x, dpp_f<0x4E>(x)); return fmaxf(x, dpp_f<0x141>(x)); }
__device__ __forceinline__ int grp8_min(int x) { x = min(x, dpp_i<0xB1>(x)); x = min(x, dpp_i<0x4E>(x)); return min(x, dpp_i<0x141>(x)); }
__device__ __forceinline__ void nsa_attn_phase(unsigned char* lds, const bf16_t* PB, const bf16_t* KCb, const bf16_t* VCb, const float* qn, const float* kn3, unsigned* ctr, bf16_t* AO) {
    using L = NsaLds;
    constexpr float SCALE = 0.08838834764831845f;
    const int tid = threadIdx.x, wid = tid >> 6, lane = tid & 63, r32 = lane & 31, hi = lane >> 5;
    float* impw = (float*)(lds + NSA_IMP) + wid * (8 * 160);
    unsigned* combw = (unsigned*)(lds + NSA_COMB) + wid * (32 * 64) + lane;
    unsigned* selm = (unsigned*)(lds + NSA_SELM);
    unsigned char* lws = lds + L::WS0;
    const float gqmax = max_abs128(qn, lane);
    const float qk_sel = 128.f * 1.02f * gqmax * max_abs128(kn3 + 128, lane), qk_win = 128.f * 1.02f * gqmax * max_abs128(kn3 + 256, lane), qk_cmp = 128.f * 1.02f * gqmax * max_abs128(kn3, lane);
    volatile LAS int* slot = (volatile LAS int*)(lds + L::TOTAL + 64);
    const int xq = (int)blockIdx.x & 7, qtype = (xq >> 1) & 1, idx4 = (xq & 1) | ((xq >> 2) << 1);
    for (;;) {
        if (tid == 0) *slot = (int)__hip_atomic_fetch_add(ctr + xq * 8, 1u, __ATOMIC_RELAXED, __HIP_MEMORY_SCOPE_AGENT);
        __syncthreads();
        const int ui = *slot;
        if (ui >= (qtype ? 68 : 60)) break;
        int g, k;
        if (!qtype) { if (ui < 32) { g = 3; k = ui; } else if (ui < 36) { g = 1; k = ui - 32; } else { g = 0; k = ui - 36; } }
        else { if (ui < 32) { g = 2; k = ui; } else if (ui < 60) { g = 1; k = ui - 28; } else { g = 0; k = ui - 36; } }
        const int tb = 4 * (31 - k) + idx4;
        const int T0w = tb * 64 + wid * 8;
        const int tokl = T0w + (r32 >> 2), hl = g * 4 + (r32 & 3), qpos = tokl;
        const float nslope = -alibi_slope(hl) / SCALE;
        const bf16_t* rowl = PB + (size_t)tokl * LD3;
        bf16x8 qr[8];
        load_q<128>(rowl + hl * 128, hi, qr);
        norm_q128(qr, qn, hi);
        NsaCmpPol cpol{KCb + (size_t)g * 512 * 128, VCb + (size_t)g * 512 * 128, tb >> 4, T0w + 7, qpos, nslope, qk_cmp};
        f32x16 o[4] = {}; float m_reg = -1e30f, l_reg = 0.f; int kt_cmp_lo = 0;
        flash_pass<NsaCmpPol>(cpol, lds, qr, o, m_reg, l_reg, &kt_cmp_lo);
        for (int i = lane; i < 8 * 160; i += 64) impw[i] = 0.f;
        asm volatile("s_waitcnt lgkmcnt(0)" ::: "memory");
        nsa_importance(cpol, kt_cmp_lo, lds, qr, m_reg, l_reg, impw);
        if (tb < 16) {
            if (lane < 8) { unsigned* q = selm + (wid * 8 + lane) * 4; q[0] = (1u << (tb + 1)) - 1u; q[1] = 0u; q[2] = 0u; q[3] = 0u; }
        } else {
            const int ti = lane >> 3, sub = lane & 7;
            const float* iv = impw + ti * 160 + sub * 16;
            float v[16];
#pragma unroll
            for (int q4 = 0; q4 < 4; ++q4) { const f32x4 t = *(const f32x4*)(iv + q4 * 4); v[q4 * 4] = t[0]; v[q4 * 4 + 1] = t[1]; v[q4 * 4 + 2] = t[2]; v[q4 * 4 + 3] = t[3]; }
#pragma unroll
            for (int j = 0; j < 16; ++j) { const int n = sub * 16 + j; v[j] = (n >= 1 && n <= tb - 2) ? v[j] : -INFINITY; }
            unsigned sel16 = 0u;
            for (int r = 0; r < 13; ++r) {
                float lm = v[0];
#pragma unroll
                for (int j = 1; j < 16; ++j) lm = fmaxf(lm, v[j]);
                const float gm = grp8_max(lm);
                int cand = 999;
#pragma unroll
                for (int j = 15; j >= 0; --j) cand = (v[j] == gm) ? (sub * 16 + j) : cand;
                const int jw = grp8_min(cand) - sub * 16;
                const bool mine = (gm > -INFINITY) && ((unsigned)jw < 16u);
#pragma unroll
                for (int j = 0; j < 16; ++j) v[j] = (mine && j == jw) ? -INFINITY : v[j];
                sel16 |= mine ? (1u << jw) : 0u;
            }
            unsigned w = (sub & 1) ? (sel16 << 16) : sel16;
            w |= (unsigned)__builtin_amdgcn_update_dpp(0, (int)w, 0xB1, 0xF, 0xF, true);
            const int word = sub >> 1;
            unsigned fw = word == 0 ? 1u : 0u;
            if (((tb - 1) >> 5) == word) fw |= 1u << ((tb - 1) & 31);
            if ((tb >> 5) == word) fw |= 1u << (tb & 31);
            if ((sub & 1) == 0) selm[(wid * 8 + ti) * 4 + word] = w | fw;
        }
        __syncthreads();
        unsigned u0, u1, u2, u3;
        { const unsigned* q = selm + lane * 4; u0 = wave_or(q[0]); u1 = wave_or(q[1]); u2 = wave_or(q[2]); u3 = wave_or(q[3]);
          u0 = __builtin_amdgcn_readfirstlane(u0); u1 = __builtin_amdgcn_readfirstlane(u1); u2 = __builtin_amdgcn_readfirstlane(u2); u3 = __builtin_amdgcn_readfirstlane(u3); }
        float fr[16];
        row_factor(lws, l_reg > 0.f ? sigmoid_f(bf2f(rowl[5120 + hl * 3])) * __builtin_amdgcn_rcpf(l_reg) : 0.f, fr);
#pragma unroll
        for (int d0 = 0; d0 < 4; ++d0)
#pragma unroll
            for (int r = 0; r < 16; r += 2) combw[(d0 * 8 + (r >> 1)) * 64] = cvtpk(o[d0][r] * fr[r], o[d0][r + 1] * fr[r + 1]);
        {
            NsaSelPol spol{PB, g, tb, qpos, -nslope, aug_split(-nslope), qk_sel, selm + (wid * 8 + (r32 >> 2)) * 4, u0, u1, u2, u3};
#pragma unroll
            for (int d = 0; d < 4; ++d) o[d] = f32x16{};
            m_reg = -1e30f; l_reg = 0.f;
            flash_pass<NsaSelPol>(spol, lds, qr, o, m_reg, l_reg);
            row_factor(lws, l_reg > 0.f ? sigmoid_f(bf2f(rowl[5120 + hl * 3 + 1])) * __builtin_amdgcn_rcpf(l_reg) : 0.f, fr);
#pragma unroll
            for (int d0 = 0; d0 < 4; ++d0)
#pragma unroll
                for (int r = 0; r < 16; r += 2) { const unsigned c = combw[(d0 * 8 + (r >> 1)) * 64];
                    combw[(d0 * 8 + (r >> 1)) * 64] = cvtpk(__uint_as_float(c << 16) + o[d0][r] * fr[r], __uint_as_float(c & 0xffff0000u) + o[d0][r + 1] * fr[r + 1]); }
        }
        {
            NsaWinPol wpol{PB, g, tb, qpos, -nslope, aug_split(-nslope), qk_win};
#pragma unroll
            for (int d = 0; d < 4; ++d) o[d] = f32x16{};
            m_reg = -1e30f; l_reg = 0.f;
            flash_pass<NsaWinPol>(wpol, lds, qr, o, m_reg, l_reg);
            row_factor(lws, l_reg > 0.f ? sigmoid_f(bf2f(rowl[5120 + hl * 3 + 2])) * __builtin_amdgcn_rcpf(l_reg) : 0.f, fr);
#pragma unroll
            for (int r = 0; r < 16; ++r) { const int rw = crow(r, hi), tok = T0w + (rw >> 2), hh = g * 4 + (rw & 3);
                const bf16_t* gt = PB + (size_t)tok * LD3 + 5168 + hh * 128; bf16_t* ao = AO + (size_t)tok * DM + hh * 128;
#pragma unroll
                for (int d0 = 0; d0 < 4; ++d0) { const int col = d0 * 32 + r32; const unsigned c = combw[(d0 * 8 + (r >> 1)) * 64];
                    const float cv = (r & 1) ? __uint_as_float(c & 0xffff0000u) : __uint_as_float(c << 16);
                    ao[col] = f2bf((cv + o[d0][r] * fr[r]) * silu_f(bf2f(gt[col]))); } }
        }
        __syncthreads();
    }
}

typedef float f32x4v __attribute__((ext_vector_type(4)));
__device__ __forceinline__ void nsa_compress_phase(unsigned char* lds, const bf16_t* PB, const bf16_t* WCK, const bf16_t* WCV, const long long* c0, const float* gain, bf16_t* KC, bf16_t* VC) {
    const int tid = threadIdx.x, wid = tid >> 6, lane = tid & 63, row = lane & 15, kq = lane >> 4;
    float* part = (float*)lds;
    for (int u = blockIdx.x; u < 256; u += gridDim.x) {
        const int which = u & 1, g = (u >> 1) & 3, n0 = (u >> 3) * 16;
        const bf16_t* Wt = which ? WCV : WCK; const int col0 = (which ? 2560 : 2048) + g * 128;
        f32x4v acc[8];
#pragma unroll
        for (int ct = 0; ct < 8; ++ct) acc[ct] = f32x4v{0.f, 0.f, 0.f, 0.f};
#pragma unroll 4
        for (int kk = wid * 16; kk < wid * 16 + 16; ++kk) {
            const int l = kk >> 2, d = (kk & 3) * 32 + kq * 8;
            const bf16x8 a = *(const bf16x8*)(PB + (size_t)(16 * (n0 + row) + l) * LD3 + col0 + d);
#pragma unroll
            for (int ct = 0; ct < 8; ++ct) { const bf16x8 b = *(const bf16x8*)(Wt + (size_t)(ct * 16 + row) * 4096 + kk * 32 + kq * 8);
                acc[ct] = __builtin_amdgcn_mfma_f32_16x16x32_bf16(a, b, acc[ct], 0, 0, 0); }
        }
#pragma unroll
        for (int ct = 0; ct < 8; ++ct)
#pragma unroll
            for (int jj = 0; jj < 4; ++jj) part[(wid * 16 + kq * 4 + jj) * 128 + ct * 16 + row] = acc[ct][jj];
        __syncthreads();
        const int r = tid >> 5, c4 = (tid & 31) * 4;
        f32x4v s; { const long long* cp = c0 + which * 128 + c4; s[0] = (float)((double)cp[0] * (1.0 / 68719476736.0)); s[1] = (float)((double)cp[1] * (1.0 / 68719476736.0));
                    s[2] = (float)((double)cp[2] * (1.0 / 68719476736.0)); s[3] = (float)((double)cp[3] * (1.0 / 68719476736.0)); }
#pragma unroll
        for (int w = 0; w < 8; ++w) s += *(const f32x4v*)(part + (w * 16 + r) * 128 + c4);
        if (which == 0) {
            float ss = (s[0] * s[0] + s[1] * s[1]) + (s[2] * s[2] + s[3] * s[3]);
            for (int o = 16; o > 0; o >>= 1) ss += __shfl_xor(ss, o);
            const float rinv = rsqrtf(ss * (1.f / 128.f) + 1e-6f);
            const f32x4v gv = *(const f32x4v*)(gain + c4);
            s = s * rinv * gv;
        }
        const int n = n0 + r;
        if (n == 511) s = f32x4v{0.f, 0.f, 0.f, 0.f};
        uint2 wv; wv.x = cvtpk(s[0], s[1]); wv.y = cvtpk(s[2], s[3]);
        *(uint2*)((which ? VC : KC) + ((size_t)g * 512 + n) * 128 + c4) = wv;
        __syncthreads();
    }
}
__device__ __forceinline__ void nsa_c0_phase(const float* pos, const float* wk, const float* wv, long long* c0) {
    const int tid = threadIdx.x;
    if (tid >= 256) return;
    const int which = tid >> 7, c = tid & 127;
    const float* W = which ? wv : wk;
    float s = 0.f;
    for (int k = blockIdx.x * 16; k < blockIdx.x * 16 + 16; ++k) s += pos[k] * W[(size_t)k * 128 + c];
    atomicAdd((unsigned long long*)(c0 + which * 128 + c), (unsigned long long)(long long)llrint((double)s * 68719476736.0));
}

__device__ __forceinline__ void nsa_c0_direct(int j, const float* __restrict__ pos, const float* __restrict__ wk, const float* __restrict__ wv, long long* __restrict__ c0, unsigned char* lds) {
    const int tid = threadIdx.x, which = j >> 5, cb = (j & 31) * 4, cc = tid & 3, ks = tid >> 2;
    const float* W = (which ? wv : wk) + cb + cc;
    float s = 0.f;
#pragma unroll 8
    for (int i = 0; i < 32; ++i) { const int k = ks * 32 + i; s += pos[k] * W[(size_t)k * 128]; }
    float* red = (float*)lds;
    red[tid] = s;
    __syncthreads();
    for (int stride = 64; stride > 0; stride >>= 1) { if (ks < stride) red[tid] += red[tid + stride * 4]; __syncthreads(); }
    if (tid < 4) c0[which * 128 + cb + tid] = (long long)llrint((double)red[tid] * 68719476736.0);
    __syncthreads();
}
}


namespace tp {
__device__ __forceinline__ unsigned cvtpk(float lo, float hi) { unsigned r; asm volatile("v_cvt_pk_bf16_f32 %0, %1, %2" : "=v"(r) : "v"(lo), "v"(hi)); return r; }
__device__ __forceinline__ void unpack8(const u32x4 w, float (&f)[8]) {
    f[0] = __uint_as_float(w.x << 16); f[1] = __uint_as_float(w.x & 0xffff0000u); f[2] = __uint_as_float(w.y << 16); f[3] = __uint_as_float(w.y & 0xffff0000u);
    f[4] = __uint_as_float(w.z << 16); f[5] = __uint_as_float(w.z & 0xffff0000u); f[6] = __uint_as_float(w.w << 16); f[7] = __uint_as_float(w.w & 0xffff0000u);
}
__device__ __forceinline__ u32x4 pack8(const float (&f)[8]) { u32x4 w; w.x = cvtpk(f[0], f[1]); w.y = cvtpk(f[2], f[3]); w.z = cvtpk(f[4], f[5]); w.w = cvtpk(f[6], f[7]); return w; }
template <int GROUP> __device__ __forceinline__ float group_sum(float v) {
#pragma unroll
    for (int o = GROUP / 2; o > 0; o >>= 1) v += __shfl_xor(v, o);
    return v;
}
template <int GROUP> __device__ __forceinline__ void norm8(const bf16_t* p, const float* g, float (&f)[8]) {
    unpack8(*(const u32x4*)p, f);
    float ss = 0.f;
#pragma unroll
    for (int e = 0; e < 8; ++e) ss += f[e] * f[e];
    ss = group_sum<GROUP>(ss);
    const float r = rsqrtf(ss * (1.f / (8.f * GROUP)) + 1e-6f);
    const f32x4 g0 = *(const f32x4*)g, g1 = *(const f32x4*)(g + 4);
    f[0] *= r * g0[0]; f[1] *= r * g0[1]; f[2] *= r * g0[2]; f[3] *= r * g0[3]; f[4] *= r * g1[0]; f[5] *= r * g1[1]; f[6] *= r * g1[2]; f[7] *= r * g1[3];
}
template <int GROUP> __device__ __forceinline__ void norm8v(const u32x4 w, const float* g, float (&f)[8]) {
    unpack8(w, f);
    float ss = 0.f;
#pragma unroll
    for (int e = 0; e < 8; ++e) ss += f[e] * f[e];
    ss = group_sum<GROUP>(ss);
    const float r = rsqrtf(ss * (1.f / (8.f * GROUP)) + 1e-6f);
    const f32x4 g0 = *(const f32x4*)g, g1 = *(const f32x4*)(g + 4);
    f[0] *= r * g0[0]; f[1] *= r * g0[1]; f[2] *= r * g0[2]; f[3] *= r * g0[3]; f[4] *= r * g1[0]; f[5] *= r * g1[1]; f[6] *= r * g1[2]; f[7] *= r * g1[3];
}
__device__ __forceinline__ void rmsnorm_phase(const float* __restrict__ x, const float* __restrict__ g, bf16_t* __restrict__ out) {
    const int wid = threadIdx.x >> 6, lane = threadIdx.x & 63;
#pragma unroll 4
    for (int row = blockIdx.x * 8 + wid; row < SEQ; row += gridDim.x * 8) {
        const f32x4* xr = (const f32x4*)(x + (size_t)row * DM);
        f32x4 v[8]; float ss = 0.f;
#pragma unroll
        for (int i = 0; i < 8; ++i) { v[i] = xr[i * 64 + lane]; ss += (v[i][0] * v[i][0] + v[i][1] * v[i][1]) + (v[i][2] * v[i][2] + v[i][3] * v[i][3]); }
        ss = wave_sum(ss);
        const float r = rsqrtf(ss * (1.f / DM) + 1e-6f);
        uint2* o = (uint2*)(out + (size_t)row * DM);
#pragma unroll
        for (int i = 0; i < 8; ++i) { const f32x4 gv = ((const f32x4*)g)[i * 64 + lane]; uint2 w; w.x = cvtpk(v[i][0] * r * gv[0], v[i][1] * r * gv[1]); w.y = cvtpk(v[i][2] * r * gv[2], v[i][3] * r * gv[3]); o[i * 64 + lane] = w; }
    }
}
struct ConvJob { const float* W; bf16_t* Wt; int K, N; const float* g; };
__device__ __forceinline__ int conv_tiles(const ConvJob& j) { return (j.K / 128) * ((j.N + 127) / 128); }
struct ConvRegs { f32x4 a[4], b[4]; };
__device__ __forceinline__ void conv_load(const ConvJob& j, int tile, ConvRegs& r) {
    const int tid = threadIdx.x, K = j.K, N = j.N, nkt = K / 128;
    const int n4 = (tid & 31) * 4, kp = tid >> 5;
    const int k0 = (tile % nkt) * 128, n0 = (tile / nkt) * 128;
#pragma unroll
    for (int s = 0; s < 4; ++s) {
        const int kpair = kp + 16 * s;
        r.a[s] = f32x4{0.f, 0.f, 0.f, 0.f}; r.b[s] = f32x4{0.f, 0.f, 0.f, 0.f};
        if (n0 + n4 < N) { const float* wp = j.W + (size_t)(k0 + 2 * kpair) * N + n0 + n4; r.a[s] = *(const f32x4*)wp; r.b[s] = *(const f32x4*)(wp + N);
            if (j.g) { const float ga = j.g[k0 + 2 * kpair], gb = j.g[k0 + 2 * kpair + 1]; r.a[s] *= ga; r.b[s] *= gb; } }
    }
}
__device__ __forceinline__ void conv_finish(const ConvJob& j, int tile, const ConvRegs& r, unsigned char* lds) {
    const int tid = threadIdx.x, K = j.K, N = j.N, nkt = K / 128;
    LAS unsigned* T = (LAS unsigned*)lds;
    const int n4 = (tid & 31) * 4, kp = tid >> 5;
    const int sn = tid >> 2, skc = (tid & 3) * 16;
    const int k0 = (tile % nkt) * 128, n0 = (tile / nkt) * 128;
#pragma unroll
    for (int s = 0; s < 4; ++s) { const int kpair = kp + 16 * s;
#pragma unroll
        for (int jj = 0; jj < 4; ++jj) T[(n4 + jj) * 65 + kpair] = cvtpk(r.a[s][jj], r.b[s][jj]); }
    __syncthreads();
    if (n0 + sn < N) {
        bf16_t* dst = j.Wt + (size_t)(n0 + sn) * K + k0 + skc * 2;
#pragma unroll
        for (int q = 0; q < 4; ++q) { u32x4 v; v.x = T[sn * 65 + skc + 4 * q]; v.y = T[sn * 65 + skc + 4 * q + 1]; v.z = T[sn * 65 + skc + 4 * q + 2]; v.w = T[sn * 65 + skc + 4 * q + 3];
            *(u32x4*)(dst + 8 * q) = v; }
    }
    __syncthreads();
}
__device__ __forceinline__ void conv_wT(const float* __restrict__ W, bf16_t* __restrict__ Wt, int K, int N, unsigned char* lds, const float* g = nullptr) {
    const ConvJob j{W, Wt, K, N, g};
    const int nt = conv_tiles(j);
    int tile = blockIdx.x;
    ConvRegs ra, rb;
    if (tile < nt) conv_load(j, tile, ra);
    while (tile < nt) {
        const int nx = tile + gridDim.x;
        if (nx < nt) conv_load(j, nx, rb);
        conv_finish(j, tile, ra, lds);
        ra = rb; tile = nx;
    }
}
__device__ __forceinline__ void conv_static3(const ConvJob& j0, const ConvJob& j1, const ConvJob& j2, int first, int stride, unsigned char* lds) {
    const int n0 = conv_tiles(j0), n1 = n0 + conv_tiles(j1), n2 = n1 + conv_tiles(j2);
#define CS_JOB(t) ((t) < n0 ? j0 : (t) < n1 ? j1 : j2)
#define CS_LOCAL(t) ((t) < n0 ? (t) : (t) < n1 ? (t) - n0 : (t) - n1)
    ConvRegs ra, rb;
    int t = first;
    if (t < n2) conv_load(CS_JOB(t), CS_LOCAL(t), ra);
    while (t < n2) {
        const int tn = t + stride;
        if (tn < n2) conv_load(CS_JOB(tn), CS_LOCAL(tn), rb);
        conv_finish(CS_JOB(t), CS_LOCAL(t), ra, lds);
        ra = rb; t = tn;
    }
#undef CS_JOB
#undef CS_LOCAL
}
__device__ __forceinline__ void rope_slice(float* tab, int e0, int n) {
    for (int idx = e0 + (int)threadIdx.x; idx < e0 + n; idx += 512) {
        const int pos = idx >> 5, i = idx & 31;
        const float inv = powf(10000.f, -(float)(2 * i) / 64.f);
        const double a = (double)((float)pos * inv);
        tab[idx * 2 + 0] = (float)cos(a); tab[idx * 2 + 1] = (float)sin(a);
    }
}
__device__ __forceinline__ void conv_drain(const ConvJob& j0, const ConvJob& j1, const ConvJob& j2, const ConvJob& j3, unsigned* ctr, unsigned* arr, unsigned char* lds) {
    const int n0 = conv_tiles(j0), n1 = n0 + conv_tiles(j1), n2 = n1 + conv_tiles(j2), n3 = n2 + conv_tiles(j3);
    volatile LAS int* slot = (volatile LAS int*)(lds + 34816);
    __syncthreads();
    if (arr && threadIdx.x == 0) (void)__hip_atomic_fetch_add(arr, 1u, __ATOMIC_RELAXED, __HIP_MEMORY_SCOPE_AGENT);
#define CD_PULL() do { if (threadIdx.x == 0) { \
        if (arr && __hip_atomic_load(arr, __ATOMIC_RELAXED, __HIP_MEMORY_SCOPE_AGENT) >= gridDim.x) *slot = 0x7fffffff; \
        else *slot = (int)__hip_atomic_fetch_add(ctr, 1u, __ATOMIC_RELAXED, __HIP_MEMORY_SCOPE_AGENT); } } while (0)
#define CD_JOB(t) ((t) < n0 ? j0 : (t) < n1 ? j1 : (t) < n2 ? j2 : j3)
#define CD_LOCAL(t) ((t) < n0 ? (t) : (t) < n1 ? (t) - n0 : (t) < n2 ? (t) - n1 : (t) - n2)
    ConvRegs ra, rb;
    CD_PULL(); __syncthreads();
    int t = *slot;
    if (t < n3) conv_load(CD_JOB(t), CD_LOCAL(t), ra);
    while (t < n3) {
        __syncthreads();
        CD_PULL(); __syncthreads();
        const int tn = *slot;
        if (tn < n3) conv_load(CD_JOB(tn), CD_LOCAL(tn), rb);
        conv_finish(CD_JOB(t), CD_LOCAL(t), ra, lds);
        ra = rb; t = tn;
    }
#undef CD_PULL
#undef CD_JOB
#undef CD_LOCAL
    __syncthreads();
}
__device__ __forceinline__ void moba_prep_phase(bf16_t* __restrict__ PB, const float* __restrict__ qn, const float* __restrict__ kn, float* __restrict__ KPART, unsigned char* lds) {
    const int tid = threadIdx.x, wid = tid >> 6, lane = tid & 63;
    float ks[4][8];
#pragma unroll
    for (int i = 0; i < 4; ++i)
#pragma unroll
        for (int e = 0; e < 8; ++e) ks[i][e] = 0.f;
    u32x4 kin[4][4];
#pragma unroll
    for (int t = 0; t < 4; ++t)
#pragma unroll
        for (int i = 0; i < 4; ++i) kin[t][i] = *(const u32x4*)(PB + (size_t)(blockIdx.x * 32 + wid * 4 + t) * 8192 + 2048 + (i * 64 + lane) * 8);
#pragma unroll
    for (int t = 0; t < 4; ++t) {
        const int tok = blockIdx.x * 32 + wid * 4 + t;
        bf16_t* row = PB + (size_t)tok * 8192;
        float f[8];
#pragma unroll
        for (int i = 0; i < 4; ++i) { bf16_t* p = row + 2048 + (i * 64 + lane) * 8; norm8v<16>(kin[t][i], kn + (lane & 15) * 8, f); const u32x4 w = pack8(f); *(u32x4*)p = w;
            float fr[8]; unpack8(w, fr);
#pragma unroll
            for (int e = 0; e < 8; ++e) ks[i][e] += fr[e]; }
    }
    float* red = (float*)lds;
#pragma unroll
    for (int i = 0; i < 4; ++i) { float* d = red + wid * 2048 + (i * 64 + lane) * 8; *(f32x4*)d = f32x4{ks[i][0], ks[i][1], ks[i][2], ks[i][3]}; *(f32x4*)(d + 4) = f32x4{ks[i][4], ks[i][5], ks[i][6], ks[i][7]}; }
    __syncthreads();
    f32x4 s = *(const f32x4*)(red + tid * 4);
#pragma unroll
    for (int w = 1; w < 8; ++w) s += *(const f32x4*)(red + w * 2048 + tid * 4);
    *(f32x4*)(KPART + (size_t)blockIdx.x * 2048 + tid * 4) = s;
    __syncthreads();
}
__device__ __forceinline__ void nsa_prep_phase(bf16_t* __restrict__ PB, const float* __restrict__ qn, const float* __restrict__ kn3) {
    const int wid = threadIdx.x >> 6, lane = threadIdx.x & 63;
    for (int tok0 = blockIdx.x * 8 + wid; tok0 < SEQ; tok0 += gridDim.x * 8 * 4) {
        u32x4 a[4], b[4];
#pragma unroll
        for (int j = 0; j < 4; ++j) { const int tok = tok0 + j * gridDim.x * 8; if (tok < SEQ) { const bf16_t* row = PB + (size_t)tok * LD3; a[j] = *(const u32x4*)(row + 3072 + lane * 8); b[j] = *(const u32x4*)(row + 4096 + lane * 8); } }
#pragma unroll
        for (int j = 0; j < 4; ++j) { const int tok = tok0 + j * gridDim.x * 8; if (tok < SEQ) { bf16_t* row = PB + (size_t)tok * LD3; float f[8];
            norm8v<16>(a[j], kn3 + 128 + (lane & 15) * 8, f); *(u32x4*)(row + 3072 + lane * 8) = pack8(f);
            norm8v<16>(b[j], kn3 + 256 + (lane & 15) * 8, f); *(u32x4*)(row + 4096 + lane * 8) = pack8(f); } }
    }
}
}

namespace fa {
__device__ __forceinline__ void mla_kvup_phase(unsigned char* lds, const bf16_t* __restrict__ KVL, const bf16_t* __restrict__ Wt, const pg8::u64acc* __restrict__ kvss,
                                               const float* __restrict__ knorm, const float* __restrict__ rope, const bf16_t* __restrict__ PB,
                                               bf16_t* __restrict__ KVU, bf16_t* __restrict__ KR) {
    const int tid = threadIdx.x, wid = tid >> 6, lane = tid & 63, r32 = lane & 31, hi = lane >> 5;
    const int h = (int)blockIdx.x & 15, pbase = (int)blockIdx.x >> 4;
    {
        for (int t = 0; t < 4; ++t) { const int tok = (int)blockIdx.x * 32 + wid * 4 + t; const int l8 = lane & 7;
            float f[8]; tp::norm8<8>(PB + (size_t)tok * 3072 + 768 + l8 * 8, knorm + 128 + l8 * 8, f);
            const float* cs = rope + ((size_t)tok * 32 + (l8 & 3) * 8) * 2;
            float o[8];
#pragma unroll
            for (int e = 0; e < 8; ++e) { const float other = __shfl_xor(f[e], 4); const float c = cs[2 * e], s = cs[2 * e + 1]; o[e] = (l8 < 4) ? (f[e] * c - other * s) : (other * s + f[e] * c); }
            if (lane < 8) *(u32x4*)(KR + (size_t)tok * 64 + lane * 8) = tp::pack8(o); }
    }
#pragma unroll 4
    for (int i = 0; i < 16; ++i) { const int idx = tid + 512 * i, row = idx >> 5, c = idx & 31;
        const u32x4 v = *(const u32x4*)(Wt + ((size_t)(h * 256 + row)) * 256 + c * 8);
        *(LAS u32x4*)(lds + row * 512 + ((c ^ (row & 15)) << 4)) = v; }
    __syncthreads();
    const int sw = r32 & 15;
    for (int u = 0; u < 2; ++u) {
        const int tok = (pbase + 16 * u) * 256 + wid * 32 + r32;
        const float st = rsqrtf(pg8::acc_get_fx(kvss + tok) * (1.f / 256.f) + 1e-6f);
        bf16x8 xf[16];
#pragma unroll
        for (int ks = 0; ks < 16; ++ks) xf[ks] = *(const bf16x8*)(KVL + (size_t)tok * 256 + ks * 16 + hi * 8);
        bf16_t* orow = KVU + (size_t)tok * 4096 + h * 256;
        f32x16 ak[4];
#pragma unroll
        for (int blk = 0; blk < 4; ++blk) { ak[blk] = f32x16{};
#pragma unroll
            for (int ks = 0; ks < 16; ++ks) { const bf16x8 a = *(const LAS bf16x8*)(lds + (blk * 32 + r32) * 512 + (((ks * 2 + hi) ^ sw) << 4));
                ak[blk] = __builtin_amdgcn_mfma_f32_32x32x16_bf16(a, xf[ks], ak[blk], 0, 0, 0); } }
        float ss = 0.f;
#pragma unroll
        for (int blk = 0; blk < 4; ++blk)
#pragma unroll
            for (int r = 0; r < 16; ++r) { ak[blk][r] *= st; ss += ak[blk][r] * ak[blk][r]; }
        ss = pair_sum(ss);
        const float rk = rsqrtf(ss * (1.f / 128.f) + 1e-6f);
#pragma unroll
        for (int blk = 0; blk < 4; ++blk)
#pragma unroll
            for (int g4 = 0; g4 < 4; ++g4) { const int c0 = blk * 32 + 8 * g4 + 4 * hi; const f32x4 gn = *(const f32x4*)(knorm + c0);
                uint2 w; w.x = cvtpk(ak[blk][4 * g4] * rk * gn[0], ak[blk][4 * g4 + 1] * rk * gn[1]); w.y = cvtpk(ak[blk][4 * g4 + 2] * rk * gn[2], ak[blk][4 * g4 + 3] * rk * gn[3]);
                *(uint2*)(orow + c0) = w; }
#pragma unroll
        for (int blk = 4; blk < 8; ++blk) { f32x16 av = {};
#pragma unroll
            for (int ks = 0; ks < 16; ++ks) { const bf16x8 a = *(const LAS bf16x8*)(lds + (blk * 32 + r32) * 512 + (((ks * 2 + hi) ^ sw) << 4));
                av = __builtin_amdgcn_mfma_f32_32x32x16_bf16(a, xf[ks], av, 0, 0, 0); }
#pragma unroll
            for (int g4 = 0; g4 < 4; ++g4) { const int c0 = blk * 32 + 8 * g4 + 4 * hi;
                uint2 w; w.x = cvtpk(av[4 * g4] * st, av[4 * g4 + 1] * st); w.y = cvtpk(av[4 * g4 + 2] * st, av[4 * g4 + 3] * st);
                *(uint2*)(orow + c0) = w; } }
    }
    __syncthreads();
}
}

constexpr int NTHREADS = 512;
constexpr int LDS_BYTES = 163840;
constexpr int LDS_BARW = LDS_BYTES - 16;
constexpr int NPHASES = 24;
struct Args { const float* in[26]; float* out; unsigned char* ws; int ph_lo, ph_hi; };

#define VGRID(T, NBX, NBY, CALL) do { constexpr int NV_ = NTHREADS / (T); const int vsub_ = (int)threadIdx.x / (T); const int tid = (int)threadIdx.x % (T); \
    const long nblk_ = (long)(NBX) * (NBY); const long per_ = (long)gridDim.x * NV_; \
    for (long base_ = 0; base_ < nblk_; base_ += per_) { long vb_ = base_ + (long)blockIdx.x * NV_ + vsub_; const bool active = vb_ < nblk_; if (!active) vb_ = nblk_ - 1; \
        const int bx = (int)(vb_ % (NBX)), by = (int)(vb_ / (NBX)); unsigned char* sm = lds + vsub_ * 32768; (void)bx; (void)by; (void)sm; (void)active; \
        CALL; __syncthreads(); } } while (0)

__global__ void __launch_bounds__(NTHREADS, 2) fwd(Args a) {
    extern __shared__ __attribute__((aligned(1024))) unsigned char lds[];
    if (threadIdx.x == 0) *(uint4*)(lds + LDS_BARW) = make_uint4(0u, 0u, 0u, 0u);
    __syncthreads();
    unsigned char* ws = a.ws;
    XcdBarrier bar = xcd_barrier_post((unsigned*)(ws + WS_BAR), (volatile LAS unsigned*)(lds + LDS_BARW));
    const float* x = a.in[0];
    const float* norm_a = a.in[1];  const float* w_in_a = a.in[2];  const float* q_lat_norm = a.in[3];
    const float* w_q_up = a.in[4];  const float* kv_lat_norm = a.in[5]; const float* w_kv_up = a.in[6];
    const float* q_norm_a = a.in[7]; const float* k_norm_a = a.in[8]; const float* w_out_a = a.in[9];
    const float* norm_b = a.in[10]; const float* w_in_b = a.in[11]; const float* q_norm_b = a.in[12];
    const float* k_norm_b = a.in[13]; const float* w_out_b = a.in[14];
    const float* norm_c = a.in[15]; const float* w_in_c = a.in[16]; const float* w_out_c = a.in[17];
    const float* norm_d = a.in[18]; const float* w_in_d = a.in[19]; const float* q_norm_d = a.in[20];
    const float* k_norm_d = a.in[21]; const float* w_cmp_k = a.in[22]; const float* w_cmp_v = a.in[23];
    const float* cmp_pos = a.in[24]; const float* w_out_d = a.in[25];
    float* out = a.out;
    float* rope = (float*)(ws + WS_ROPE);
    bf16_t* H = (bf16_t*)(ws + WS_H); bf16_t* AO = (bf16_t*)(ws + WS_AO);
    bf16_t* QL = (bf16_t*)(ws + WS_QL); bf16_t* KVL = (bf16_t*)(ws + WS_KVL); bf16_t* KR = (bf16_t*)(ws + WS_KR);
    float* KMEAN = (float*)(ws + WS_KMEAN); bf16_t* KCMP = (bf16_t*)(ws + WS_KCMP); bf16_t* VCMP = (bf16_t*)(ws + WS_VCMP);
    bf16_t* PB = (bf16_t*)(ws + WS_ARENA + AR_PB); bf16_t* QU = (bf16_t*)(ws + WS_ARENA + AR_QU); bf16_t* KVU = (bf16_t*)(ws + WS_ARENA + AR_KVU);
    long long* C0 = (long long*)(ws + WS_C0); pg8::u64acc* RSS = (pg8::u64acc*)(ws + WS_RSS); pg8::u64acc* LSS = (pg8::u64acc*)(ws + WS_LSS);
    unsigned char* wr0 = ws + WS_W; unsigned char* wr1 = ws + WS_W + WREG;
    bf16_t* WIN0 = (bf16_t*)(wr0 + WB_IN); bf16_t* WOUT0 = (bf16_t*)(wr0 + WB_OUT); bf16_t* WQUP = (bf16_t*)(wr0 + WB_QUP); bf16_t* WKVUP = (bf16_t*)(wr0 + WB_KVUP);
    bf16_t* WIN1 = (bf16_t*)(wr1 + WB_IN); bf16_t* WOUT1 = (bf16_t*)(wr1 + WB_OUT); bf16_t* WCK = (bf16_t*)(wr1 + WB_CK); bf16_t* WCV = (bf16_t*)(wr1 + WB_CV);
    unsigned* cq = (unsigned*)(ws + WS_BAR) + CQ_WORD0;
    const tp::ConvJob jnone{nullptr, nullptr, 128, 0, nullptr};
    const tp::ConvJob jl1a{w_in_b, WIN1, DM, 8192, norm_b}, jl1b{w_out_b, WOUT1, DM, DM, nullptr};
    const tp::ConvJob jl2a{w_in_c, WIN0, DM, 8192, norm_c}, jl2b{w_out_c, WOUT0, DM, DM, nullptr};
    const tp::ConvJob jl3a{w_in_d, WIN1, DM, 7216, norm_d}, jl3b{w_out_d, WOUT1, DM, DM, nullptr}, jl3c{w_cmp_k, WCK, 4096, 128, nullptr}, jl3d{w_cmp_v, WCV, 4096, 128, nullptr};
    unsigned* arrw = (unsigned*)(ws + WS_BAR) + 3776;
#define DRAIN1(ph) tp::conv_drain(jl1a, jl1b, jnone, jnone, cq, (ph) >= 0 ? arrw + (ph) : nullptr, lds)
#define DRAIN2(ph) tp::conv_drain(jl2a, jl2b, jnone, jnone, cq + 64, (ph) >= 0 ? arrw + (ph) : nullptr, lds)
#define DRAIN3(ph) tp::conv_drain(jl3a, jnone, jnone, jnone, cq + 128, (ph) >= 0 ? arrw + (ph) : nullptr, lds)
    PG8_LAS unsigned char* glds = (PG8_LAS unsigned char*)lds;
#define GEMM_BF16(Aop, Bop, Nn, Kk, Oo, ldo) do { pg8::Gemm g_{(const pg8::bf16_t*)(Aop), (const pg8::bf16_t*)(Bop), SEQ, (Nn), (Kk)}; pg8::StaticOrder S_; S_.init(SEQ, (Nn), (int)gridDim.x, (int)blockIdx.x); \
        pg8::EpiBf16<0> E_{(pg8::bf16_t*)(Oo), (ldo), nullptr, 0, 0}; pg8::gemm_phase<pg8::EpiBf16<0>, pg8::StaticOrder>(glds, g_, S_, E_, nullptr); } while (0)
#define GEMM_BF16S(Aop, Bop, Nn, Oo, ldo, Rss) GEMM_BF16SK(Aop, Bop, Nn, DM, Oo, ldo, Rss)
#define GEMM_BF16SK(Aop, Bop, Nn, Kk, Oo, ldo, Rss) do { pg8::Gemm g_{(const pg8::bf16_t*)(Aop), (const pg8::bf16_t*)(Bop), SEQ, (Nn), (Kk)}; pg8::StaticOrder S_; S_.init(SEQ, (Nn), (int)gridDim.x, (int)blockIdx.x); \
        pg8::EpiBf16S E_{(pg8::bf16_t*)(Oo), (ldo), (Rss), 1.f / (Kk)}; pg8::gemm_phase<pg8::EpiBf16S, pg8::StaticOrder>(glds, g_, S_, E_, nullptr); } while (0)
#define GEMM_MLAIN() do { pg8::Gemm g_{(const pg8::bf16_t*)H, (const pg8::bf16_t*)WIN0, SEQ, 3072, DM}; pg8::StaticOrder S_; S_.init(SEQ, 3072, (int)gridDim.x, (int)blockIdx.x); \
        pg8::EpiMlaIn E_{(pg8::bf16_t*)PB, 3072, (pg8::bf16_t*)QL, (pg8::bf16_t*)KVL, LSS, LSS + SEQ}; pg8::gemm_phase<pg8::EpiMlaIn, pg8::StaticOrder>(glds, g_, S_, E_, nullptr); } while (0)
#define GEMM_RESX(Aop, Bop, Rr, Rss) do { pg8::Gemm g_{(const pg8::bf16_t*)(Aop), (const pg8::bf16_t*)(Bop), SEQ, DM, DM}; pg8::StaticOrder S_; S_.init(SEQ, DM, (int)gridDim.x, (int)blockIdx.x); \
        pg8::EpiResBfX<false> E_{(Rr), (pg8::bf16_t*)H, (Rss), DM, nullptr}; pg8::gemm_phase<pg8::EpiResBfX<false>, pg8::StaticOrder>(glds, g_, S_, E_, nullptr); } while (0)
#define GEMM_RESXB(Aop, Bop, Rss) do { pg8::Gemm g_{(const pg8::bf16_t*)(Aop), (const pg8::bf16_t*)(Bop), SEQ, DM, DM}; pg8::StaticOrder S_; S_.init(SEQ, DM, (int)gridDim.x, (int)blockIdx.x); \
        pg8::EpiResBfX<true> E_{nullptr, (pg8::bf16_t*)H, (Rss), DM, nullptr}; pg8::gemm_phase<pg8::EpiResBfX<true>, pg8::StaticOrder>(glds, g_, S_, E_, nullptr); } while (0)
#define GEMM_RESXBF(Aop, Bop, Rss) do { pg8::Gemm g_{(const pg8::bf16_t*)(Aop), (const pg8::bf16_t*)(Bop), SEQ, DM, DM}; pg8::StaticOrder S_; S_.init(SEQ, DM, (int)gridDim.x, (int)blockIdx.x); \
        pg8::EpiResBfX<true, true> E_{nullptr, (pg8::bf16_t*)H, (Rss), DM, out}; pg8::gemm_phase<pg8::EpiResBfX<true, true>, pg8::StaticOrder>(glds, g_, S_, E_, nullptr); } while (0)
#define GEMM_RES(Aop, Bop, Rr) do { pg8::Gemm g_{(const pg8::bf16_t*)(Aop), (const pg8::bf16_t*)(Bop), SEQ, DM, DM}; pg8::StaticOrder S_; S_.init(SEQ, DM, (int)gridDim.x, (int)blockIdx.x); \
        unsigned char* h21_ = a.ws; asm volatile("" : "+s"(h21_));     \
        pg8::EpiResBfX<true, true, true> E_{nullptr, (pg8::bf16_t*)(h21_ + WS_H), nullptr, DM, a.out}; pg8::gemm_phase<pg8::EpiResBfX<true, true, true>, pg8::StaticOrder>(glds, g_, S_, E_, nullptr); } while (0)
    const int lo = a.ph_lo, hi = a.ph_hi;
#define IN(k) (lo <= (k) && (k) < hi)
#ifndef PROBE_MASK
#define PROBE_MASK 0u
#endif
#if PROBE_MASK
    unsigned long long tph_ = wall_clock64();
#define SEAM(k) do { if ((PROBE_MASK >> (k)) & 1u) { const unsigned long long t1_ = wall_clock64(); while (wall_clock64() < t1_ + (t1_ - tph_)) __builtin_amdgcn_s_sleep(8); } \
        if (IN(k) && IN((k) + 1)) xcd_barrier(bar); tph_ = wall_clock64(); } while (0)
#else
#define SEAM(k) do { if (IN(k) && IN((k) + 1)) xcd_barrier(bar); } while (0)
#endif

    if (IN(0)) { tp::rmsnorm_phase(x, norm_a, H); tp::conv_wT(w_in_a, WIN0, DM, 2880, lds); } SEAM(0);
    if (IN(1)) { GEMM_MLAIN();
                 if (blockIdx.x >= 128) {
                     tp::rope_slice(rope, ((int)blockIdx.x - 128) * 2048, 2048);
                     const tp::ConvJob ja{w_q_up, WQUP, 512, 3072, q_lat_norm}, jb{w_kv_up, WKVUP, 256, 4096, kv_lat_norm}, jc{w_out_a, WOUT0, DM, DM, nullptr};
                     tp::conv_static3(ja, jb, jc, (int)blockIdx.x - 128, 128, lds); }
                 DRAIN1(1); } SEAM(1);
    if (IN(3)) { GEMM_BF16SK(QL, WQUP, 3072, 512, QU, 3072, LSS);
                 fa::mla_kvup_phase(lds, KVL, WKVUP, LSS + SEQ, k_norm_a, rope, PB, KVU, KR); DRAIN1(3); } SEAM(3);
    if (IN(5)) { fa::mla_attn_phase(lds, QU, KVU, KR, PB, q_norm_a, rope, AO, (unsigned*)(ws + WS_BAR) + 3968); DRAIN1(5); } SEAM(5);
    if (IN(6)) { GEMM_RESX(AO, WOUT0, x, RSS); DRAIN1(-1); } SEAM(6);
    if (IN(8)) { GEMM_BF16S(H, WIN1, 8192, PB, 8192, RSS); } SEAM(8);
    if (IN(9)) { tp::moba_prep_phase(PB, q_norm_b, k_norm_b, KMEAN, lds); fa::moba_order_phase((int*)QL); tp::conv_drain(jl2a, jl2b, jnone, jnone, cq + 64, cq, lds); } SEAM(9);
    if (IN(11)) { fa::moba_attn_phase(lds, PB, KMEAN, q_norm_b, k_norm_b, (unsigned*)(ws + WS_BAR) + 3840, (unsigned*)(ws + WS_SPLIT), ws + WS_ARENA + (size_t)SEQ * 8192 * 2, (const int*)QL, AO); DRAIN2(11); } SEAM(11);
    if (IN(12)) { GEMM_RESXB(AO, WOUT1, RSS + SEQ); DRAIN2(-1); } SEAM(12);
    if (IN(14)) { GEMM_BF16S(H, WIN0, 8192, PB, 8192, RSS + SEQ); if (hi > 1000) DRAIN3(14); } SEAM(14);
    if (IN(15)) { fa::sb_attn_phase(lds, PB, AO, (unsigned*)(ws + WS_BAR) + 3984); DRAIN3(-1); } SEAM(15);
    if (IN(16)) { GEMM_RESXB(AO, WOUT0, RSS + 2 * SEQ); DRAIN3(-1); } SEAM(16);
    if (IN(18)) { GEMM_BF16S(H, WIN1, LD3, PB, LD3, RSS + 2 * SEQ);
                  if (blockIdx.x >= 160) tp::conv_static3(jl3b, jl3c, jl3d, (int)blockIdx.x - 160, 96, lds);
                  if (blockIdx.x >= 192) fa::nsa_c0_direct((int)blockIdx.x - 192, cmp_pos, w_cmp_k, w_cmp_v, C0, lds); } SEAM(18);
    if (IN(19)) { tp::nsa_prep_phase(PB, q_norm_d, k_norm_d);
                  fa::nsa_compress_phase(lds, PB, WCK, WCV, C0, k_norm_d, KCMP, VCMP); } SEAM(19);
    if (IN(20)) { fa::nsa_attn_phase(lds, PB, KCMP, VCMP, q_norm_d, k_norm_d, (unsigned*)(ws + WS_BAR) + 3904, AO); } SEAM(20);
    if (IN(21)) { GEMM_RES(AO, WOUT1, nullptr); } SEAM(21);
#undef IN
#undef SEAM
}

#ifndef N_LAUNCH_PER_PHASE
#define N_LAUNCH_PER_PHASE 0
#endif
extern "C" void kernel_launch(void* const* d_in, const int* in_sizes, int n_in, void* d_out, int out_size, void* d_ws, size_t ws_size, hipStream_t stream) {
    static int ready = 0;
    if (ready == 0) {
        if (n_in != 26 || ws_size < WS_END) { ready = -1; return; }
        if (hipFuncSetAttribute((const void*)fwd, hipFuncAttributeMaxDynamicSharedMemorySize, LDS_BYTES) != hipSuccess) { ready = -1; return; }
        int per_cu = 0; (void)hipOccupancyMaxActiveBlocksPerMultiprocessor(&per_cu, (const void*)fwd, NTHREADS, LDS_BYTES); (void)hipGetLastError();
        ready = 1;
    }
    if (ready < 0) return;
    (void)hipMemsetAsync((char*)d_ws + WS_BAR, 0, WS_CTL_BYTES, stream);
    Args a{};
    for (int i = 0; i < 26; ++i) a.in[i] = (const float*)d_in[i];
    a.out = (float*)d_out; a.ws = (unsigned char*)d_ws;
#if N_LAUNCH_PER_PHASE
    for (int p = 0; p < 22; ++p) { a.ph_lo = p; a.ph_hi = p + 1; hipLaunchKernelGGL(fwd, dim3(256), dim3(NTHREADS), LDS_BYTES, stream, a); }
#else
    a.ph_lo = 0; a.ph_hi = 22;
    hipLaunchKernelGGL(fwd, dim3(256), dim3(NTHREADS), LDS_BYTES, stream, a);
#endif
}
```
